# Optimizing an MI355X kernel written in HIP

```python
import math
import jax, jax.numpy as jnp
from jax import lax
import numpy as np

D_MODEL = 1024
BATCH = 8
SEQ = 4096
DEPTH = 4

N_EVEN = (DEPTH + 1) // 2
N_ODD = DEPTH // 2
CONV_WIDTH = 4
NORM_EPS = 1e-6
LRU_WIDTH = D_MODEL
LRU_BLOCKS = 16
LRU_BLOCK = LRU_WIDTH // LRU_BLOCKS
LRU_C = 8.0
SSD_WIDTH = D_MODEL
SSD_HEAD_DIM = 64
SSD_HEADS = SSD_WIDTH // SSD_HEAD_DIM
SSD_GROUPS = 2
SSD_STATE = 128
SSD_CHUNK = 128
SSD_CONV_CH = SSD_WIDTH + 2 * SSD_GROUPS * SSD_STATE
REC_IN = 2 * LRU_WIDTH + SSD_WIDTH + SSD_CONV_CH + SSD_HEADS
REC_OUT = LRU_WIDTH + SSD_WIDTH
ATT_HEADS = 16
ATT_HEAD_DIM = D_MODEL // ATT_HEADS
ATT_WIDTH = ATT_HEADS * ATT_HEAD_DIM
ROPE_DIM = ATT_HEAD_DIM // 4
ROPE_THETA = 500000.0
DILATED_PATTERNS = ((128, 1), (512, 4), (2048, 16))
FFN_HIDDEN = -(-8 * D_MODEL // (3 * 256)) * 256

kernel_name = 'hybrid_rglru_ssd_dilated_attn_trunk'


def rmsnorm(x, g):
    x32 = x.astype(jnp.float32)
    y = x32 * lax.rsqrt(jnp.mean(x32 * x32, axis=-1, keepdims=True) + NORM_EPS)
    return (y * g.astype(jnp.float32)).astype(x.dtype)


def causal_dwconv(x, w, b):
    k = w.shape[0]
    l = x.shape[1]
    xp = jnp.pad(x, ((0, 0), (k - 1, 0), (0, 0)))
    y = b
    for j in range(k):
        y = y + xp[:, j:j + l] * w[j]
    return y


def rg_lru(xc, w_r, b_r, w_i, b_i, lam):
    b, l, w = xc.shape
    xb = xc.reshape(b, l, LRU_BLOCKS, LRU_BLOCK)
    r = jax.nn.sigmoid(jnp.einsum('blhi,hij->blhj', xb, w_r).reshape(b, l, w) + b_r)
    i = jax.nn.sigmoid(jnp.einsum('blhi,hij->blhj', xb, w_i).reshape(b, l, w) + b_i)
    log_a = -LRU_C * r * jax.nn.softplus(-lam)
    a = jnp.exp(log_a)
    u = jnp.sqrt(-jnp.expm1(2.0 * log_a)) * (i * xc)

    def combine(e1, e2):
        a1, h1 = e1
        a2, h2 = e2
        return a1 * a2, a2 * h1 + h2

    _, h = lax.associative_scan(combine, (a, u), axis=1)
    return h


def ssd_chunked(xs, dt, a, bm, cm):
    b, l, nh, p = xs.shape
    g, n = bm.shape[2], bm.shape[3]
    r = nh // g
    c = l // SSD_CHUNK
    t = SSD_CHUNK
    xdt = (xs * dt[..., None]).reshape(b, c, t, g, r, p)
    adt = (dt * a).reshape(b, c, t, g, r)
    bc = bm.reshape(b, c, t, g, n)
    cc = cm.reshape(b, c, t, g, n)
    cs = jnp.cumsum(adt, axis=2)
    seg = cs[:, :, :, None] - cs[:, :, None, :]
    causal = (jnp.arange(t)[:, None] >= jnp.arange(t)[None, :])[:, :, None, None]
    decay = jnp.exp(jnp.where(causal, seg, -jnp.inf))
    cb = jnp.einsum('bclgn,bcsgn->bclsg', cc, bc)
    y_diag = jnp.einsum('bclsgr,bcsgrp->bclgrp', cb[..., None] * decay, xdt)
    decay_to_end = jnp.exp(cs[:, :, -1:] - cs)
    states = jnp.einsum('bcsgn,bcsgrp->bcgrpn', bc, xdt * decay_to_end[..., None])
    chunk_decay = jnp.exp(cs[:, :, -1])

    def step(carry, inp):
        s_c, d_c = inp
        return carry * d_c[..., None, None] + s_c, carry

    init = jnp.zeros((b, g, r, p, n), jnp.float32)
    _, prev = lax.scan(step, init, (jnp.moveaxis(states, 1, 0), jnp.moveaxis(chunk_decay, 1, 0)))
    prev = jnp.moveaxis(prev, 0, 1)
    y_off = jnp.einsum('bclgn,bcgrpn->bclgrp', cc, prev) * jnp.exp(cs)[..., None]
    return (y_diag + y_off).reshape(b, l, nh, p)


def recurrent_layer(x, norm_g, w_in, lru_conv_w, lru_conv_b, lru_w_r, lru_b_r, lru_w_i, lru_b_i,
                    lru_lambda, ssd_conv_w, ssd_conv_b, ssd_dt_bias, ssd_a_log, ssd_d, ssd_norm, w_out):
    f32 = jnp.float32
    b, l, _ = x.shape
    h = rmsnorm(x, norm_g)
    proj = h @ w_in
    s1 = LRU_WIDTH
    s2 = 2 * LRU_WIDTH
    s3 = s2 + SSD_WIDTH
    s4 = s3 + SSD_CONV_CH
    lru_x, lru_gate, z, xbc, dt_raw = jnp.split(proj, [s1, s2, s3, s4], axis=-1)
    xc = causal_dwconv(lru_x, lru_conv_w, lru_conv_b).astype(f32)
    h_lru = rg_lru(xc, lru_w_r.astype(f32), lru_b_r.astype(f32), lru_w_i.astype(f32),
                   lru_b_i.astype(f32), lru_lambda.astype(f32))
    out_a = h_lru * jax.nn.gelu(lru_gate.astype(f32))
    xbc = jax.nn.silu(causal_dwconv(xbc, ssd_conv_w, ssd_conv_b).astype(f32))
    xs, bm, cm = jnp.split(xbc, [SSD_WIDTH, SSD_WIDTH + SSD_GROUPS * SSD_STATE], axis=-1)
    xs = xs.reshape(b, l, SSD_HEADS, SSD_HEAD_DIM)
    bm = bm.reshape(b, l, SSD_GROUPS, SSD_STATE)
    cm = cm.reshape(b, l, SSD_GROUPS, SSD_STATE)
    dt = jax.nn.softplus(dt_raw.astype(f32) + ssd_dt_bias.astype(f32))
    a = -jnp.exp(ssd_a_log.astype(f32))
    y = ssd_chunked(xs, dt, a, bm, cm) + ssd_d.astype(f32)[:, None] * xs
    y = y.reshape(b, l, SSD_WIDTH) * jax.nn.silu(z.astype(f32))
    y = y.reshape(b, l, SSD_GROUPS, SSD_WIDTH // SSD_GROUPS)
    y = y * lax.rsqrt(jnp.mean(y * y, axis=-1, keepdims=True) + NORM_EPS)
    out_b = y.reshape(b, l, SSD_WIDTH) * ssd_norm.astype(f32)
    mixed = jnp.concatenate([out_a, out_b], axis=-1).astype(x.dtype)
    return x + mixed @ w_out


def partial_rope(x, pos):
    half = ROPE_DIM // 2
    inv = ROPE_THETA ** (-2.0 * jnp.arange(half, dtype=jnp.float32) / ROPE_DIM)
    ang = pos[:, None] * inv[None, :]
    cos = jnp.cos(ang)[None, :, None, :]
    sin = jnp.sin(ang)[None, :, None, :]
    x1 = x[..., :half].astype(jnp.float32)
    x2 = x[..., half:ROPE_DIM].astype(jnp.float32)
    rot = jnp.concatenate([x1 * cos - x2 * sin, x2 * cos + x1 * sin], axis=-1)
    return jnp.concatenate([rot.astype(x.dtype), x[..., ROPE_DIM:]], axis=-1)


def dilated_window_attention(q, k, v, window, dilation):
    b, l, h, e = q.shape
    span = window // dilation
    u = l // dilation
    nblk = -(-u // span)
    up = nblk * span

    def to_strided(t):
        t = t.reshape(b, u, dilation, h, e).transpose(0, 2, 1, 3, 4).reshape(b * dilation, u, h, e)
        t = jnp.pad(t, ((0, 0), (0, up - u), (0, 0), (0, 0)))
        return t.reshape(b * dilation, nblk, span, h, e)

    def with_prev(t):
        prev = jnp.pad(t[:, :-1], ((0, 0), (1, 0), (0, 0), (0, 0), (0, 0)))
        return jnp.concatenate([prev, t], axis=2)

    def from_strided(t):
        tail = t.shape[3:]
        t = t.reshape((b, dilation, up) + tail)[:, :, :u]
        return jnp.swapaxes(t, 1, 2).reshape((b, l) + tail)

    qb = to_strided(q)
    kc = with_prev(to_strided(k))
    vc = with_prev(to_strided(v))
    s = jnp.einsum('bnqhe,bnkhe->bnhqk', qb, kc).astype(jnp.float32)
    qi = jnp.arange(span)[:, None]
    kj = jnp.arange(2 * span)[None, :]
    band = (kj >= qi) & (kj <= qi + span)
    valid = band[None] & ((jnp.arange(nblk)[:, None, None] > 0) | (kj[None] >= span))
    s = jnp.where(valid[None, :, None], s, -jnp.inf)
    m = jnp.max(s, axis=-1)
    p = jnp.exp(s - m[..., None])
    den = jnp.sum(p, axis=-1)
    o = jnp.einsum('bnhqk,bnkhe->bnqhe', p, vc.astype(jnp.float32))
    den_q = jnp.swapaxes(den, 2, 3)
    o = o / den_q[..., None]
    return from_strided(o), from_strided(jnp.swapaxes(m, 2, 3)), from_strided(den_q)


def attention_layer(x, norm_g, w_qkv, q_norm, k_norm, w_out):
    b, l, _ = x.shape
    h = rmsnorm(x, norm_g)
    qkv = (h @ w_qkv).reshape(b, l, 3, ATT_HEADS, ATT_HEAD_DIM)
    pos = jnp.arange(l, dtype=jnp.float32)
    q = partial_rope(rmsnorm(qkv[:, :, 0], q_norm), pos) * (ATT_HEAD_DIM ** -0.5)
    k = partial_rope(rmsnorm(qkv[:, :, 1], k_norm), pos)
    v = qkv[:, :, 2]
    outs, maxes, dens = [], [], []
    for window, dilation in DILATED_PATTERNS:
        o_i, m_i, d_i = dilated_window_attention(q, k, v, window, dilation)
        outs.append(o_i)
        maxes.append(m_i)
        dens.append(d_i)
    m_all = jnp.stack(maxes)
    wts = jnp.stack(dens) * jnp.exp(m_all - jnp.max(m_all, axis=0, keepdims=True))
    o = jnp.sum(wts[..., None] * jnp.stack(outs), axis=0) / jnp.sum(wts, axis=0)[..., None]
    o = o.astype(x.dtype).reshape(b, l, ATT_WIDTH)
    return x + o @ w_out


def swiglu_layer(x, norm_g, w_gate_up, w_down):
    h = rmsnorm(x, norm_g)
    g, u = jnp.split(h @ w_gate_up, 2, axis=-1)
    return x + (jax.nn.silu(g) * u) @ w_down


def setup_inputs(seed: int = 0) -> dict:
    key = jax.random.key(seed)
    ks = iter(jax.random.split(key, 32))
    f32 = jnp.float32
    ne, no = N_EVEN, N_ODD

    def nrm(shape, scale):
        return jax.random.normal(next(ks), shape, f32) * scale

    def gain(shape):
        return 1.0 + 0.02 * jax.random.normal(next(ks), shape, f32)

    lam_base = jax.random.uniform(next(ks), (ne, LRU_WIDTH), f32, 0.9, 0.999)
    sig = lam_base ** (1.0 / LRU_C)
    lru_lambda = jnp.log(sig) - jnp.log1p(-sig)
    dt0 = jnp.exp(jax.random.uniform(next(ks), (ne, SSD_HEADS), f32, math.log(1e-3), math.log(1e-1)))
    ssd_dt_bias = dt0 + jnp.log(-jnp.expm1(-dt0))
    ssd_a_log = jnp.log(jax.random.uniform(next(ks), (ne, SSD_HEADS), f32, 1.0, 16.0))
    inputs = {}
    inputs['x'] = nrm((BATCH, SEQ, D_MODEL), 1.0)
    inputs['rec_norm'] = gain((ne, D_MODEL))
    inputs['rec_w_in'] = nrm((ne, D_MODEL, REC_IN), D_MODEL ** -0.5)
    inputs['lru_conv_w'] = nrm((ne, CONV_WIDTH, LRU_WIDTH), CONV_WIDTH ** -0.5)
    inputs['lru_conv_b'] = nrm((ne, LRU_WIDTH), 0.02)
    inputs['lru_w_r'] = nrm((ne, LRU_BLOCKS, LRU_BLOCK, LRU_BLOCK), LRU_BLOCK ** -0.5)
    inputs['lru_b_r'] = nrm((ne, LRU_WIDTH), 0.02)
    inputs['lru_w_i'] = nrm((ne, LRU_BLOCKS, LRU_BLOCK, LRU_BLOCK), LRU_BLOCK ** -0.5)
    inputs['lru_b_i'] = nrm((ne, LRU_WIDTH), 0.02)
    inputs['lru_lambda'] = lru_lambda
    inputs['ssd_conv_w'] = nrm((ne, CONV_WIDTH, SSD_CONV_CH), CONV_WIDTH ** -0.5)
    inputs['ssd_conv_b'] = nrm((ne, SSD_CONV_CH), 0.02)
    inputs['ssd_dt_bias'] = ssd_dt_bias
    inputs['ssd_a_log'] = ssd_a_log
    inputs['ssd_d'] = 1.0 + 0.1 * jax.random.normal(next(ks), (ne, SSD_HEADS), f32)
    inputs['ssd_norm'] = gain((ne, SSD_WIDTH))
    inputs['rec_w_out'] = nrm((ne, REC_OUT, D_MODEL), REC_OUT ** -0.5)
    inputs['att_norm'] = gain((no, D_MODEL))
    inputs['att_w_qkv'] = nrm((no, D_MODEL, 3 * ATT_WIDTH), D_MODEL ** -0.5)
    inputs['att_q_norm'] = gain((no, ATT_HEAD_DIM))
    inputs['att_k_norm'] = gain((no, ATT_HEAD_DIM))
    inputs['att_w_out'] = nrm((no, ATT_WIDTH, D_MODEL), ATT_WIDTH ** -0.5)
    inputs['ffn_norm'] = gain((DEPTH, D_MODEL))
    inputs['ffn_w_gate_up'] = nrm((DEPTH, D_MODEL, 2 * FFN_HIDDEN), D_MODEL ** -0.5)
    inputs['ffn_w_down'] = nrm((DEPTH, FFN_HIDDEN, D_MODEL), FFN_HIDDEN ** -0.5)
    return inputs


def reference(x, rec_norm, rec_w_in, lru_conv_w, lru_conv_b, lru_w_r, lru_b_r, lru_w_i, lru_b_i,
              lru_lambda, ssd_conv_w, ssd_conv_b, ssd_dt_bias, ssd_a_log, ssd_d, ssd_norm, rec_w_out,
              att_norm, att_w_qkv, att_q_norm, att_k_norm, att_w_out,
              ffn_norm, ffn_w_gate_up, ffn_w_down):
    for layer in range(DEPTH):
        i = layer // 2
        if layer % 2 == 0:
            x = recurrent_layer(x, rec_norm[i], rec_w_in[i], lru_conv_w[i], lru_conv_b[i],
                                lru_w_r[i], lru_b_r[i], lru_w_i[i], lru_b_i[i], lru_lambda[i],
                                ssd_conv_w[i], ssd_conv_b[i], ssd_dt_bias[i], ssd_a_log[i],
                                ssd_d[i], ssd_norm[i], rec_w_out[i])
        else:
            x = attention_layer(x, att_norm[i], att_w_qkv[i], att_q_norm[i], att_k_norm[i],
                                att_w_out[i])
        x = swiglu_layer(x, ffn_norm[layer], ffn_w_gate_up[layer], ffn_w_down[layer])
    return x
```

```cpp
#include <hip/hip_runtime.h>
#include <hip/hip_cooperative_groups.h>
#include <cstdio>
#include <cstdint>
namespace cg = cooperative_groups;
namespace pg8 {
#define PG8_LAS __attribute__((address_space(3)))
typedef unsigned short bf16_t;
typedef short bf16x8 __attribute__((ext_vector_type(8)));
typedef float f32x4 __attribute__((ext_vector_type(4)));
typedef unsigned u32x4 __attribute__((ext_vector_type(4)));
constexpr int BM = 256, BK = 64, HALF = 128, HTB = HALF * BK * 2  , STAGE_BYTES = 8 * HTB, NXCD = 8, WGM = 8;

__host__ __device__ __forceinline__ int lds_byte(int r, int c) { const int st = (r >> 4) * 2 + (c >> 5), rr = r & 15, cc = c & 31, ob = rr * 64 + cc * 2; return st * 1024 + (ob ^ (((ob >> 9) & 1) << 5)); }
__host__ __device__ __forceinline__ void stage_rc(int b, int& R, int& C) { const int st = b / 1024, sb = b % 1024, swz = sb ^ (((sb >> 9) & 1) << 5); R = (st >> 1) * 16 + swz / 64; C = (st & 1) * 32 + (swz % 64) / 2; }
__host__ __device__ __forceinline__ int perm32(int rho) { const int n = rho >> 4, i = rho & 15; return 8 * (i >> 2) + 4 * n + (i & 3); }

struct Unit { int pm, pn; };
struct Gemm { const bf16_t* A; const bf16_t* Bt; int M, N, K, lda; };

struct StaticOrder {
    int nM, nN, nwg, G, c;
    __host__ __device__ void init(int M, int N, int G_, int c_) { nM = M / BM; nN = N / BM; nwg = nM * nN; G = G_; c = c_; }
    __host__ __device__ bool next(int i, Unit& u) const {
        const long L = (long)i * G + c; if (L >= nwg) return false;
        int wgid = (int)L; { const int q = nwg / NXCD, r = nwg % NXCD, xcd = wgid % NXCD, off = wgid / NXCD; wgid = (xcd < r ? xcd * (q + 1) : r * (q + 1) + (xcd - r) * q) + off; }
        const int nig = WGM * nN, gid = wgid / nig, fm = gid * WGM, gsz = (nM - fm) < WGM ? (nM - fm) : WGM;
        u.pm = fm + ((wgid % nig) % gsz); u.pn = (wgid % nig) / gsz; return true;
    }
    __device__ __forceinline__ void a_ready(const Unit&) const {}
    __device__ __forceinline__ void done(const Unit&) const {}
};

__device__ __forceinline__ unsigned cvt_pk_bf16(float lo, float hi) { unsigned r; asm volatile("v_cvt_pk_bf16_f32 %0, %1, %2" : "=v"(r) : "v"(lo), "v"(hi)); return r; }
typedef float f32x2 __attribute__((ext_vector_type(2)));
__device__ __forceinline__ float fast_exp(float x) { return __builtin_amdgcn_exp2f(x * 1.4426950408889634f); }
__device__ __forceinline__ float fast_sigmoid(float x) { return __builtin_amdgcn_rcpf(1.0f + fast_exp(-x)); }
__device__ __forceinline__ float fast_silu(float x) { return x * fast_sigmoid(x); }

struct EpiProj {
    static constexpr bool PERM = true, AFTER_DRAIN = false;
    bf16_t* O; int ldc; float* dt; int dt_pn;
    __device__ __forceinline__ void operator()(const f32x4 (&acc)[2][2][4][2], const Unit& u, int wr, int wc, int fr, int fq) const {
        const int row0 = u.pm * BM + wr * 64 + fr; const int col0 = u.pn * BM + wc * 32 + 8 * fq;
#pragma unroll
        for (int ai = 0; ai < 2; ++ai)
#pragma unroll
            for (int m = 0; m < 4; ++m) { const int row = row0 + ai * HALF + m * 16; bf16_t* rowp = O + (size_t)row * ldc + col0;
#pragma unroll
                for (int bj = 0; bj < 2; ++bj) { const f32x4 v0 = acc[ai][bj][m][0], v1 = acc[ai][bj][m][1];
                    u32x4 w; w.x = cvt_pk_bf16(v0[0], v0[1]); w.y = cvt_pk_bf16(v0[2], v0[3]); w.z = cvt_pk_bf16(v1[0], v1[1]); w.w = cvt_pk_bf16(v1[2], v1[3]);
                    *(u32x4*)(rowp + bj * HALF) = w; }
                if (u.pn == dt_pn && wc == 0 && fq < 2) { float* dp = dt + (size_t)row * 16 + 8 * fq; *(f32x4*)dp = acc[ai][0][m][0]; *(f32x4*)(dp + 4) = acc[ai][0][m][1]; } }
    }
};
struct EpiSwiglu {
    static constexpr bool PERM = true, AFTER_DRAIN = false;
    bf16_t* O; int ldc;
    __device__ __forceinline__ void operator()(const f32x4 (&acc)[2][2][4][2], const Unit& u, int wr, int wc, int fr, int fq) const {
        const int row0 = u.pm * BM + wr * 64 + fr; const int col0 = u.pn * HALF + wc * 32 + 8 * fq;
#pragma unroll
        for (int ai = 0; ai < 2; ++ai)
#pragma unroll
            for (int m = 0; m < 4; ++m) { bf16_t* rowp = O + (size_t)(row0 + ai * HALF + m * 16) * ldc + col0;
                float o[8];
#pragma unroll
                for (int n = 0; n < 2; ++n)
#pragma unroll
                    for (int e = 0; e < 4; ++e) { const float gv = acc[ai][0][m][n][e], uv = acc[ai][1][m][n][e]; o[n * 4 + e] = fast_silu(gv) * uv; }
                u32x4 w; w.x = cvt_pk_bf16(o[0], o[1]); w.y = cvt_pk_bf16(o[2], o[3]); w.z = cvt_pk_bf16(o[4], o[5]); w.w = cvt_pk_bf16(o[6], o[7]);
                *(u32x4*)rowp = w; }
    }
};
struct EpiRes {
    static constexpr bool PERM = false, AFTER_DRAIN = false;
    const float* base; float* out; int ldc;
    __device__ __forceinline__ void operator()(const f32x4 (&acc)[2][2][4][2], const Unit& u, int wr, int wc, int fr, int fq) const {
        const int row0 = u.pm * BM + wr * 64 + fr; const int col0 = u.pn * BM + wc * 32 + 4 * fq;
#pragma unroll
        for (int ai = 0; ai < 2; ++ai)
#pragma unroll
            for (int m = 0; m < 4; ++m) { const size_t off = (size_t)(row0 + ai * HALF + m * 16) * ldc + col0;
#pragma unroll
                for (int bj = 0; bj < 2; ++bj)
#pragma unroll
                    for (int n = 0; n < 2; ++n) { const f32x4 bs = *(const f32x4*)(base + off + bj * HALF + n * 16); *(f32x4*)(out + off + bj * HALF + n * 16) = bs + acc[ai][bj][m][n]; } }
    }
};
template <class Epi, class Sched, bool ALIGN_EPI = false, bool SP2 = false>
__device__ __forceinline__ void gemm_phase(PG8_LAS unsigned char* lds, const Gemm g, const Sched& S, const Epi& E, const int tid) {
    const int wid = __builtin_amdgcn_readfirstlane(tid >> 6), lane = tid & 63, wr = wid >> 2, wc = wid & 3, fr = lane & 15, fq = lane >> 4;
    const int K = g.K, nt = K / BK;
    unsigned voffA[2], voffB[2];
#pragma unroll
    for (int i = 0; i < 2; ++i) { int R, C; stage_rc(tid * 16 + i * 8192, R, C); const int Rb = Epi::PERM ? ((R & ~31) + perm32(R & 31)) : R;
        voffA[i] = (unsigned)(R * g.lda + C) * 2u; voffB[i] = (unsigned)(Rb * K + C) * 2u; }
    const size_t kstep = (size_t)(BK * 2);
    const size_t hstepA = (size_t)HALF * g.lda * 2, hstepB = (size_t)HALF * K * 2;
    const size_t tstepA = 2 * hstepA, tstepB = 2 * hstepB;
    const unsigned ldsw = (unsigned)wid * 1024u;
    const int aoff = lds_byte(wr * 64 + fr, fq * 8), boff = lds_byte(wc * 32 + fr, fq * 8);
#define PG8_SA(b, h) (((b) * 2 + (h)) * HTB)
#define PG8_SB(b, h) ((4 + (b) * 2 + (h)) * HTB)
#define PG8_STAGE(bufoff, gbase, voff) do { _Pragma("unroll") for (int _i = 0; _i < 2; ++_i) \
        __builtin_amdgcn_global_load_lds((const unsigned*)((const char*)(gbase) + (voff)[_i]), (PG8_LAS unsigned*)(lds + (bufoff) + ldsw + _i * 8192), 16, 0, 0); } while (0)
#define PG8_LDA(dst, b, h) do { _Pragma("unroll") for (int m = 0; m < 4; ++m) _Pragma("unroll") for (int k = 0; k < 2; ++k) dst[m][k] = *(const PG8_LAS bf16x8*)(lds + PG8_SA(b, h) + aoff + m * 2048 + k * 1024); } while (0)
#define PG8_LDB(dst, b, h) do { _Pragma("unroll") for (int n = 0; n < 2; ++n) _Pragma("unroll") for (int k = 0; k < 2; ++k) dst[n][k] = *(const PG8_LAS bf16x8*)(lds + PG8_SB(b, h) + boff + n * 2048 + k * 1024); } while (0)
#define PG8_MMA(ai, bj, At, Bt) do { __builtin_amdgcn_s_setprio(1); _Pragma("unroll") for (int m = 0; m < 4; ++m) _Pragma("unroll") for (int n = 0; n < 2; ++n) _Pragma("unroll") for (int k = 0; k < 2; ++k) \
        acc[ai][bj][m][n] = __builtin_amdgcn_mfma_f32_16x16x32_bf16(Bt[n][k], At[m][k], acc[ai][bj][m][n], 0, 0, 0); __builtin_amdgcn_s_setprio(0); } while (0)
#define PG8_WAIT_V(n) asm volatile("s_waitcnt vmcnt(" #n ")" ::: "memory")
#define PG8_WAIT_L(n) asm volatile("s_waitcnt lgkmcnt(" #n ")" ::: "memory")
#define PG8_BAR __builtin_amdgcn_s_barrier()
#define PG8_SCHED __builtin_amdgcn_sched_barrier(0)
    Unit cur, nxt; int ui = 0;
    if (!S.next(0, cur)) return;
    f32x4 acc[2][2][4][2];
#pragma unroll
    for (int a = 0; a < 2; ++a)
#pragma unroll
        for (int b = 0; b < 2; ++b)
#pragma unroll
            for (int m = 0; m < 4; ++m)
#pragma unroll
                for (int n = 0; n < 2; ++n) acc[a][b][m][n] = (f32x4){0.f, 0.f, 0.f, 0.f};
    bf16x8 At[4][2], B0[2][2], B1[2][2];
    const char* cA = (const char*)g.A + (size_t)cur.pm * tstepA; const char* cB = (const char*)g.Bt + (size_t)cur.pn * tstepB;
    S.a_ready(cur);
    if constexpr (SP2) {
        PG8_STAGE(PG8_SB(0, 0), cB, voffB); PG8_STAGE(PG8_SB(0, 1), cB + hstepB, voffB); PG8_STAGE(PG8_SA(0, 0), cA, voffA); PG8_STAGE(PG8_SA(0, 1), cA + hstepA, voffA);
        if (wr == 1) PG8_BAR;
        PG8_WAIT_V(2); PG8_BAR;
        PG8_STAGE(PG8_SB(1, 0), cB + kstep, voffB); PG8_STAGE(PG8_SA(1, 0), cA + kstep, voffA); PG8_STAGE(PG8_SB(1, 1), cB + hstepB + kstep, voffB);
        PG8_WAIT_V(6); PG8_BAR;
    } else {
        PG8_STAGE(PG8_SB(0, 0), cB, voffB); PG8_STAGE(PG8_SA(0, 0), cA, voffA); PG8_STAGE(PG8_SB(0, 1), cB + hstepB, voffB); PG8_STAGE(PG8_SA(0, 1), cA + hstepA, voffA);
        if (wr == 1) PG8_BAR;
        PG8_WAIT_V(4); PG8_BAR;
        PG8_STAGE(PG8_SB(1, 0), cB + kstep, voffB); PG8_STAGE(PG8_SA(1, 0), cA + kstep, voffA); PG8_STAGE(PG8_SB(1, 1), cB + hstepB + kstep, voffB);
        PG8_WAIT_V(6); PG8_BAR;
    }
    for (;;) {
        const bool has_next = S.next(ui + 1, nxt);
        const char* nA = has_next ? (const char*)g.A + (size_t)nxt.pm * tstepA : cA; const char* nB = has_next ? (const char*)g.Bt + (size_t)nxt.pn * tstepB : cB;
        for (int t = 0; t < nt; t += 2) {
            const bool last = (t == nt - 2);
            const char* a1 = cA + (size_t)(t + 1) * kstep;
            const char* a2 = last ? nA : cA + (size_t)(t + 2) * kstep; const char* b2 = last ? nB : cB + (size_t)(t + 2) * kstep;
            const char* a3 = a2 + kstep; const char* b3 = b2 + kstep;
            if (last && has_next) S.a_ready(nxt);
            if constexpr (SP2) {
            PG8_LDB(B0, 0, 0); PG8_LDB(B1, 0, 1); PG8_SCHED; PG8_LDA(At, 0, 0); PG8_STAGE(PG8_SA(1, 1), a1 + hstepA, voffA);
            PG8_WAIT_V(8); PG8_WAIT_L(0); PG8_BAR; PG8_MMA(0, 0, At, B0); PG8_MMA(0, 1, At, B1); PG8_BAR; PG8_SCHED;
            PG8_LDA(At, 0, 1); PG8_STAGE(PG8_SB(0, 0), b2, voffB); PG8_STAGE(PG8_SB(0, 1), b2 + hstepB, voffB); PG8_STAGE(PG8_SA(0, 0), a2, voffA);
            PG8_WAIT_V(8); PG8_WAIT_L(0); PG8_BAR; PG8_MMA(1, 0, At, B0); PG8_MMA(1, 1, At, B1); PG8_BAR; PG8_SCHED;
            PG8_LDB(B0, 1, 0); PG8_LDB(B1, 1, 1); PG8_SCHED; PG8_LDA(At, 1, 0); PG8_STAGE(PG8_SA(0, 1), a2 + hstepA, voffA);
            PG8_WAIT_V(8); PG8_WAIT_L(0); PG8_BAR; PG8_MMA(0, 0, At, B0); PG8_MMA(0, 1, At, B1); PG8_BAR; PG8_SCHED;
            PG8_LDA(At, 1, 1); PG8_STAGE(PG8_SB(1, 0), b3, voffB); PG8_STAGE(PG8_SB(1, 1), b3 + hstepB, voffB); PG8_STAGE(PG8_SA(1, 0), a3, voffA);
            PG8_WAIT_V(8); PG8_WAIT_L(0); PG8_BAR; PG8_MMA(1, 0, At, B0); PG8_MMA(1, 1, At, B1); PG8_BAR; PG8_SCHED;
            } else {
            PG8_LDB(B0, 0, 0); PG8_SCHED; PG8_LDA(At, 0, 0); PG8_STAGE(PG8_SA(1, 1), a1 + hstepA, voffA);
            PG8_WAIT_L(8); PG8_BAR; PG8_WAIT_L(0); PG8_MMA(0, 0, At, B0); PG8_BAR; PG8_SCHED;
            PG8_LDB(B1, 0, 1); PG8_STAGE(PG8_SB(0, 0), b2, voffB);
            PG8_BAR; PG8_WAIT_L(0); PG8_MMA(0, 1, At, B1); PG8_BAR;
            PG8_LDA(At, 0, 1); PG8_STAGE(PG8_SA(0, 0), a2, voffA);
            PG8_BAR; PG8_WAIT_L(0); PG8_MMA(1, 0, At, B0); PG8_BAR; PG8_SCHED;
            PG8_STAGE(PG8_SB(0, 1), b2 + hstepB, voffB);
            PG8_WAIT_V(6); PG8_BAR; PG8_MMA(1, 1, At, B1); PG8_BAR;
            PG8_LDB(B0, 1, 0); PG8_SCHED; PG8_LDA(At, 1, 0); PG8_STAGE(PG8_SA(0, 1), a2 + hstepA, voffA);
            PG8_WAIT_L(8); PG8_BAR; PG8_WAIT_L(0); PG8_MMA(0, 0, At, B0); PG8_BAR; PG8_SCHED;
            PG8_LDB(B1, 1, 1); PG8_STAGE(PG8_SB(1, 0), b3, voffB);
            PG8_BAR; PG8_WAIT_L(0); PG8_MMA(0, 1, At, B1); PG8_BAR;
            PG8_LDA(At, 1, 1); PG8_STAGE(PG8_SA(1, 0), a3, voffA);
            PG8_BAR; PG8_WAIT_L(0); PG8_MMA(1, 0, At, B0); PG8_BAR; PG8_SCHED;
            PG8_STAGE(PG8_SB(1, 1), b3 + hstepB, voffB);
            PG8_WAIT_V(6); PG8_BAR; PG8_MMA(1, 1, At, B1); PG8_BAR;
            }
        }
        if constexpr (ALIGN_EPI) { if (wr == 0) PG8_BAR; }
        if constexpr (!Epi::AFTER_DRAIN) { E(acc, cur, wr, wc, fr, fq); S.done(cur); }
        if (!has_next) break;
#pragma unroll
        for (int a = 0; a < 2; ++a)
#pragma unroll
            for (int b = 0; b < 2; ++b)
#pragma unroll
                for (int m = 0; m < 4; ++m)
#pragma unroll
                    for (int n = 0; n < 2; ++n) acc[a][b][m][n] = (f32x4){0.f, 0.f, 0.f, 0.f};
        cur = nxt; cA = nA; cB = nB; ++ui;
        if constexpr (ALIGN_EPI) { if (wr == 1) PG8_BAR; }
    }
    PG8_WAIT_V(0);
    if constexpr (!ALIGN_EPI) { if (wr == 0) PG8_BAR; }
    PG8_BAR;
    if constexpr (Epi::AFTER_DRAIN) { E.fused(acc, cur, wr, wc, fr, fq, lds, wid, lane); S.done(cur); }
#undef PG8_SA
#undef PG8_SB
#undef PG8_STAGE
#undef PG8_LDA
#undef PG8_LDB
#undef PG8_MMA
#undef PG8_WAIT_V
#undef PG8_WAIT_L
#undef PG8_BAR
#undef PG8_SCHED
}
}
#define LAS __attribute__((address_space(3)))
typedef unsigned short bf16;
typedef short bf16x8 __attribute__((ext_vector_type(8)));
typedef float f32x4 __attribute__((ext_vector_type(4)));
typedef unsigned u32x4 __attribute__((ext_vector_type(4)));
typedef unsigned u32x2 __attribute__((ext_vector_type(2)));
constexpr int BATCH = 8, SEQ = 4096, DM = 1024, M = BATCH * SEQ, DEPTH = 4;
constexpr int REC_IN = 4624, PROJ_LD = 4864, REC_OUT = 2048, QKV_LD = 3072, FFN_H = 2816, GU_N = 5632;
constexpr int C_LRUX = 0, C_GATE = 1024, C_Z = 2048, C_XS = 3072, C_B = 4096, C_C = 4352;
constexpr float EPS = 1e-6f;
constexpr int NWAVES = 8, NTHREADS = 512;
constexpr int LDS_BYTES = 147456;
constexpr size_t MiB = 1u << 20;
constexpr size_t W_REC_IN = 0, W_REC_OUT = 19922944, W_QKV = 28311552, W_ATT_OUT = 40894464, W_GU = 45088768, W_DOWN = 91226112, W_LRU = 114294784, W_END = 114819072;
constexpr size_t SZ_REC_IN = 9961472, SZ_REC_OUT = 4194304, SZ_QKV = 6291456, SZ_ATT_OUT = 2097152, SZ_GU = 11534336, SZ_DOWN = 5767168, SZ_LRU = 131072;
constexpr size_t WS_H = 110 * MiB, WS_PROJ = 174 * MiB, WS_DT = 478 * MiB, WS_HALO = 481 * MiB, WS_SSQ = 489 * MiB, WS_END = 493 * MiB;
static_assert(W_END <= WS_H && WS_H + (size_t)M * DM * 2 <= WS_PROJ && WS_PROJ + (size_t)M * PROJ_LD * 2 <= WS_DT && WS_HALO + (size_t)BATCH * 64 * 3 * 2560 * 2 <= WS_END, "ws map");

__device__ __forceinline__ unsigned f2bf(float f) { unsigned u = __builtin_bit_cast(unsigned, f); return (u + 0x7fffu + ((u >> 16) & 1u)) >> 16; }
__device__ __forceinline__ float bf2f(unsigned h) { return __builtin_bit_cast(float, h << 16); }
__device__ __forceinline__ unsigned pk2(float lo, float hi) { return f2bf(lo) | (f2bf(hi) << 16); }
__device__ __forceinline__ float bflo(unsigned w) { return __builtin_bit_cast(float, w << 16); }
__device__ __forceinline__ float bfhi(unsigned w) { return __builtin_bit_cast(float, w & 0xffff0000u); }
__device__ __forceinline__ void unpack8(const u32x4 v, float* x) { x[0] = bflo(v.x); x[1] = bfhi(v.x); x[2] = bflo(v.y); x[3] = bfhi(v.y); x[4] = bflo(v.z); x[5] = bfhi(v.z); x[6] = bflo(v.w); x[7] = bfhi(v.w); }
__device__ __forceinline__ u32x4 pack8(const float* x) { u32x4 v; v.x = pk2(x[0], x[1]); v.y = pk2(x[2], x[3]); v.z = pk2(x[4], x[5]); v.w = pk2(x[6], x[7]); return v; }
#define LDS_FENCE() asm volatile("s_waitcnt lgkmcnt(0)" ::: "memory")
__device__ __forceinline__ float wave_sum(float v) {
#pragma unroll
    for (int o = 1; o < 64; o <<= 1) v += __shfl_xor(v, o);
    return v;
}
__device__ __forceinline__ float softplus_f(float x) { return x > 20.f ? x : log1pf(__expf(x)); }
__device__ __forceinline__ float gelu_tanh(float x) { const float y = 0.7978845608028654f * (x + 0.044715f * x * x * x); const float e = pg8::fast_exp(2.f * y); const float t = 1.f - 2.f * __builtin_amdgcn_rcpf(e + 1.f); return 0.5f * x * (1.f + t); }

struct Ctx {
    LAS unsigned char* lds; int tid, lane, wave, G, bid;
    float* out; unsigned char* ws;
};

__device__ __forceinline__ void transpose_item(const float* W, int K, int ldw, int ncv, int src_col0, bf16* WT, int dst_row0, LAS float* scr, int k0, int lane) {
    const int col = src_col0 + (lane & 31); const bool ok = col < ncv;
#pragma unroll 8
    for (int i = 0; i < 32; ++i) { const int kk = 2 * i + (lane >> 5); scr[kk * 33 + (lane & 31)] = ok ? W[(size_t)(k0 + kk) * ldw + col] : 0.f; }
    LDS_FENCE();
    const int c = lane & 7;
#pragma unroll
    for (int jj = 0; jj < 4; ++jj) { const int n = (lane >> 3) + 8 * jj; const LAS float* s = scr + (8 * c) * 33 + n;
        u32x4 o; o.x = pk2(s[0 * 33], s[1 * 33]); o.y = pk2(s[2 * 33], s[3 * 33]); o.z = pk2(s[4 * 33], s[5 * 33]); o.w = pk2(s[6 * 33], s[7 * 33]);
        *(u32x4*)(WT + (size_t)(dst_row0 + n) * K + k0 + 8 * c) = o; }
    LDS_FENCE();
}
__device__ __forceinline__ void p0_weights(Ctx& F, const float* w_rec_in, const float* w_rec_out, const float* w_qkv, const float* w_att_out, const float* w_gu, const float* w_down, const float* w_lr, const float* w_li) {
    LAS float* scr = (LAS float*)(F.lds + F.wave * 8448);
    const int gw = F.bid * NWAVES + F.wave, NGW = F.G * NWAVES;
    constexpr int TOTAL = 4864 + 2048 + 3072 + 1024 + 11264 + 5632;
    for (int it = gw; it < TOTAL; it += NGW) {
        int r = it; const float* W; int K, ldw, ncv, nbn, kind = 0; bf16* WT;
        if (r < 4864) { const int i = r / 2432; r %= 2432; W = w_rec_in + (size_t)i * 1024 * REC_IN; K = 1024; ldw = REC_IN; ncv = REC_IN; nbn = 152; WT = (bf16*)(F.ws + W_REC_IN + i * SZ_REC_IN); }
        else { r -= 4864;
        if (r < 2048) { const int i = r / 1024; r %= 1024; W = w_rec_out + (size_t)i * 2048 * 1024; K = 2048; ldw = 1024; ncv = 1024; nbn = 32; WT = (bf16*)(F.ws + W_REC_OUT + i * SZ_REC_OUT); }
        else { r -= 2048;
        if (r < 3072) { const int i = r / 1536; r %= 1536; W = w_qkv + (size_t)i * 1024 * 3072; K = 1024; ldw = 3072; ncv = 3072; nbn = 96; WT = (bf16*)(F.ws + W_QKV + i * SZ_QKV); }
        else { r -= 3072;
        if (r < 1024) { const int i = r / 512; r %= 512; W = w_att_out + (size_t)i * 1024 * 1024; K = 1024; ldw = 1024; ncv = 1024; nbn = 32; WT = (bf16*)(F.ws + W_ATT_OUT + i * SZ_ATT_OUT); }
        else { r -= 1024;
        if (r < 11264) { const int l = r / 2816; r %= 2816; W = w_gu + (size_t)l * 1024 * GU_N; K = 1024; ldw = GU_N; ncv = GU_N; nbn = 176; kind = 1; WT = (bf16*)(F.ws + W_GU + l * SZ_GU); }
        else { r -= 11264; const int l = r / 1408; r %= 1408; W = w_down + (size_t)l * FFN_H * 1024; K = FFN_H; ldw = 1024; ncv = 1024; nbn = 32; WT = (bf16*)(F.ws + W_DOWN + l * SZ_DOWN); } } } } }
        const int kb = r / nbn, nb = r % nbn, n0 = 32 * nb; int src = n0;
        if (kind == 1) { const int tile = n0 >> 8, within = n0 & 255; src = within < 128 ? 128 * tile + within : FFN_H + 128 * tile + (within - 128); }
        transpose_item(W, K, ldw, ncv, src, WT, n0, scr, 64 * kb, F.lane);
    }
    const int gt = F.bid * NTHREADS + F.tid, NT = F.G * NTHREADS;
    for (int idx = gt; idx < 4 * 65536; idx += NT) { const int mat = idx >> 16, e = idx & 65535, h = e >> 12, jj = (e >> 6) & 63, ii = e & 63;
        const float* src = (mat & 1) ? w_li : w_lr; const int layer = mat >> 1;
        ((bf16*)(F.ws + W_LRU))[(size_t)mat * 65536 + e] = (bf16)f2bf(src[(size_t)layer * 65536 + h * 4096 + ii * 64 + jj]); }
}
__device__ __forceinline__ void norm_phase(Ctx& F, const float* x, const float* gain, bf16* out) {
    const int gw = F.bid * NWAVES + F.wave, NGW = F.G * NWAVES;
    f32x4 gv[4];
#pragma unroll
    for (int jj = 0; jj < 4; ++jj) gv[jj] = ((const f32x4*)gain)[F.lane + 64 * jj];
    for (int m = gw; m < M; m += NGW) {
        const f32x4* xr = (const f32x4*)(x + (size_t)m * DM) + F.lane; f32x4 v[4]; float s = 0.f;
#pragma unroll
        for (int jj = 0; jj < 4; ++jj) { v[jj] = xr[64 * jj]; s += (v[jj].x * v[jj].x + v[jj].y * v[jj].y) + (v[jj].z * v[jj].z + v[jj].w * v[jj].w); }
        const float rs = 1.0f / sqrtf(wave_sum(s) * (1.f / DM) + EPS);
        u32x2* o8 = (u32x2*)(out + (size_t)m * DM) + F.lane;
#pragma unroll
        for (int jj = 0; jj < 4; ++jj) { u32x2 w; w.x = pk2(v[jj].x * rs * gv[jj].x, v[jj].y * rs * gv[jj].y); w.y = pk2(v[jj].z * rs * gv[jj].z, v[jj].w * rs * gv[jj].w); o8[64 * jj] = w; }
    }
}
__device__ __forceinline__ void halo_phase(Ctx& F) {
    const bf16* proj = (const bf16*)(F.ws + WS_PROJ); bf16* halo = (bf16*)(F.ws + WS_HALO);
    const int gw = F.bid * NWAVES + F.wave, NGW = F.G * NWAVES;
    for (int hr = gw; hr < BATCH * 64 * 3; hr += NGW) {
        const int b = hr / 192, rem = hr % 192, c = rem / 3, jj = rem % 3, t = c * 64 - 3 + jj;
#pragma unroll
        for (int q = 0; q < 5; ++q) { const int gidx = F.lane + 64 * q; const int col = gidx < 128 ? gidx * 8 : C_XS + (gidx - 128) * 8;
            u32x4 v = (u32x4){0u, 0u, 0u, 0u}; if (t >= 0) v = *(const u32x4*)(proj + (size_t)(b * SEQ + t) * PROJ_LD + col);
            *(u32x4*)(halo + (size_t)hr * 2560 + gidx * 8) = v; }
    }
}
__device__ __forceinline__ void conv_phase(Ctx& F, int li, const float* lcw, const float* lcb, const float* scw, const float* scb) {
    bf16* proj = (bf16*)(F.ws + WS_PROJ); const bf16* halo = (const bf16*)(F.ws + WS_HALO);
    if (F.tid >= 320) return;
    const int gidx = F.tid; const bool ssd = gidx >= 128; const int col = ssd ? C_XS + (gidx - 128) * 8 : gidx * 8;
    const float* cw = ssd ? scw + (size_t)li * 4 * 1536 + (gidx - 128) * 8 : lcw + (size_t)li * 4 * 1024 + gidx * 8;
    const float* cb = ssd ? scb + (size_t)li * 1536 + (gidx - 128) * 8 : lcb + (size_t)li * 1024 + gidx * 8;
    const int cstride = ssd ? 1536 : 1024;
    float w[4][8], bias[8];
#pragma unroll
    for (int jj = 0; jj < 4; ++jj)
#pragma unroll
        for (int e = 0; e < 8; ++e) w[jj][e] = cw[jj * cstride + e];
#pragma unroll
    for (int e = 0; e < 8; ++e) bias[e] = cb[e];
    for (int it = F.bid; it < BATCH * 64; it += F.G) {
        const int b = it >> 6, c = it & 63;
        float p3[8], p2[8], p1[8];
        { const bf16* hp = halo + (size_t)(it * 3) * 2560 + gidx * 8;
          unpack8(*(const u32x4*)hp, p3); unpack8(*(const u32x4*)(hp + 2560), p2); unpack8(*(const u32x4*)(hp + 5120), p1); }
        bf16* pp = proj + (size_t)(b * SEQ + c * 64) * PROJ_LD + col;
#pragma unroll 4
        for (int t = 0; t < 64; ++t) {
            float cur[8], y[8]; unpack8(*(const u32x4*)(pp + (size_t)t * PROJ_LD), cur);
#pragma unroll
            for (int e = 0; e < 8; ++e) { float v = bias[e] + w[0][e] * p3[e] + w[1][e] * p2[e] + w[2][e] * p1[e] + w[3][e] * cur[e]; if (ssd) v = pg8::fast_silu(v); y[e] = v; p3[e] = p2[e]; p2[e] = p1[e]; p1[e] = cur[e]; }
            *(u32x4*)(pp + (size_t)t * PROJ_LD) = pack8(y);
        }
    }
}
#define MFMA16(a, b, c) __builtin_amdgcn_mfma_f32_16x16x32_bf16((a), (b), (c), 0, 0, 0)
__device__ __forceinline__ void lru_item(Ctx& F, int li, int b, int blk, const float* p_br, const float* p_bi, const float* p_lam) {
    LAS float* sa = (LAS float*)F.lds;
    LAS float* su = sa + 128 * 68;
    LAS float* segA = su + 128 * 68;
    LAS float* segH = segA + 512;
    const int lane = F.lane, wave = F.wave, j = lane & 15, g = lane >> 4;
    const bf16* WrT = (const bf16*)(F.ws + W_LRU) + (size_t)(2 * li) * 65536 + blk * 4096;
    const bf16* WiT = (const bf16*)(F.ws + W_LRU) + (size_t)(2 * li + 1) * 65536 + blk * 4096;
    bf16x8 br[4][2], bi[4][2]; float biasr[4], biasi[4], c8sp[4];
#pragma unroll
    for (int nt = 0; nt < 4; ++nt) {
#pragma unroll
        for (int ks = 0; ks < 2; ++ks) { br[nt][ks] = *(const bf16x8*)(WrT + (16 * nt + j) * 64 + 32 * ks + 8 * g); bi[nt][ks] = *(const bf16x8*)(WiT + (16 * nt + j) * 64 + 32 * ks + 8 * g); }
        const int c = li * 1024 + blk * 64 + 16 * nt + j; biasr[nt] = p_br[c]; biasi[nt] = p_bi[c]; c8sp[nt] = 8.0f * log1pf(__expf(-p_lam[c])); }
    float hprev = 0.f;
    bf16* xbase = (bf16*)(F.ws + WS_PROJ) + (size_t)b * SEQ * PROJ_LD + blk * 64;
    for (int ch = 0; ch < 32; ++ch) {
        const int t0 = ch * 128 + 16 * wave;
        const bf16* ap = xbase + (size_t)(t0 + j) * PROJ_LD + 8 * g;
        const bf16x8 a0 = *(const bf16x8*)ap, a1 = *(const bf16x8*)(ap + 32);
#pragma unroll
        for (int nt = 0; nt < 4; ++nt) {
            f32x4 dr = (f32x4){0.f, 0.f, 0.f, 0.f}, di = (f32x4){0.f, 0.f, 0.f, 0.f};
            dr = MFMA16(a0, br[nt][0], dr); dr = MFMA16(a1, br[nt][1], dr);
            di = MFMA16(a0, bi[nt][0], di); di = MFMA16(a1, bi[nt][1], di);
#pragma unroll
            for (int r = 0; r < 4; ++r) { const int tl = 16 * wave + 4 * g + r, c = 16 * nt + j;
                const float xc = bf2f(xbase[(size_t)(ch * 128 + tl) * PROJ_LD + c]);
                const float rg = pg8::fast_sigmoid(dr[r] + biasr[nt]), ig = pg8::fast_sigmoid(di[r] + biasi[nt]);
                const float la = -rg * c8sp[nt]; const float a = __expf(la); const float u = sqrtf(-expm1f(2.f * la)) * ig * xc;
                sa[tl * 68 + c] = a; su[tl * 68 + c] = u; } }
        __syncthreads();
        { float A = 1.f, H = 0.f;
#pragma unroll
          for (int k = 0; k < 16; ++k) { const int idx = (16 * wave + k) * 68 + lane; const float a = sa[idx], u = su[idx]; H = a * H + u; A = A * a; su[idx] = H; sa[idx] = A; }
          segA[wave * 64 + lane] = A; segH[wave * 64 + lane] = H; }
        __syncthreads();
        float carry = hprev, hp = hprev;
#pragma unroll
        for (int w2 = 0; w2 < 8; ++w2) { const float A = segA[w2 * 64 + lane], H = segH[w2 * 64 + lane]; if (w2 == wave) carry = hp; hp = A * hp + H; }
        hprev = hp;
        bf16* gp = xbase + C_GATE + (size_t)(ch * 128 + 16 * wave) * PROJ_LD + lane;
#pragma unroll 4
        for (int k = 0; k < 16; ++k) { const int idx = (16 * wave + k) * 68 + lane; const float h = su[idx] + sa[idx] * carry;
            const float gate = bf2f(gp[(size_t)k * PROJ_LD]); gp[(size_t)k * PROJ_LD] = (bf16)f2bf(h * gelu_tanh(gate)); }
        __syncthreads();
    }
}
template <int K>
__device__ __forceinline__ f32x4 mma_lds(f32x4 acc, const LAS bf16* A, int pitchA, int rowA0, const LAS bf16* Bt, int pitchB, int rowB0, int j, int g) {
#pragma unroll
    for (int ks = 0; ks < K / 32; ++ks) { const bf16x8 a = *(const LAS bf16x8*)(A + (rowA0 + j) * pitchA + 32 * ks + 8 * g); const bf16x8 bb = *(const LAS bf16x8*)(Bt + (rowB0 + j) * pitchB + 32 * ks + 8 * g); acc = MFMA16(a, bb, acc); }
    return acc;
}
__device__ __forceinline__ void ssd_item(Ctx& F, int li, int b, int head, const float* p_dtb, const float* p_alog, const float* p_d) {
    LAS bf16* Cs = (LAS bf16*)F.lds;
    LAS bf16* Bs = Cs + 64 * 136;
    LAS bf16* BT = Bs + 64 * 136;
    LAS bf16* XT = BT + 128 * 72;
    LAS bf16* XwT = XT + 64 * 72;
    LAS bf16* Ms = XwT + 64 * 72;
    LAS bf16* Ss = Ms + 64 * 72;
    LAS float* csv = (LAS float*)(Ss + 64 * 136);
    LAS float* dtv = csv + 64;
    LAS float* wv = dtv + 64;
    const int tid = F.tid, lane = F.lane, wave = F.wave, j = lane & 15, g = lane >> 4, grp = head >> 3;
    const float a_h = -__expf(p_alog[li * 16 + head]), dtb = p_dtb[li * 16 + head], Dh = p_d[li * 16 + head];
    bf16* proj = (bf16*)(F.ws + WS_PROJ) + (size_t)b * SEQ * PROJ_LD;
    const bf16* pB = proj + C_B + 128 * grp; const bf16* pC = proj + C_C + 128 * grp; const bf16* pX = proj + C_XS + 64 * head; bf16* pZ = proj + C_Z + 64 * head;
    const float* dtp = (const float*)(F.ws + WS_DT) + (size_t)b * SEQ * 16 + head;
    float* ssq = (float*)(F.ws + WS_SSQ) + (size_t)b * SEQ * 32 + grp * 16 + (head & 7) * 2 + (wave & 1);
    f32x4 sacc[4];
#pragma unroll
    for (int pt = 0; pt < 4; ++pt) sacc[pt] = (f32x4){0.f, 0.f, 0.f, 0.f};
    for (int i = tid; i < 64 * 136 / 2; i += NTHREADS) ((LAS unsigned*)Ss)[i] = 0u;
    const int row = tid >> 3, cseg = (tid & 7) * 8;
    u32x4 rB0, rB1, rC0, rC1, rX; float rdt = 0.f;
    { const size_t o = (size_t)row * PROJ_LD + cseg; rB0 = *(const u32x4*)(pB + o); rB1 = *(const u32x4*)(pB + o + 64); rC0 = *(const u32x4*)(pC + o); rC1 = *(const u32x4*)(pC + o + 64); rX = *(const u32x4*)(pX + o);
      if (wave == 0) rdt = dtp[(size_t)lane * 16]; }
    for (int c = 0; c < 64; ++c) {
        const int tok0 = c * 64;
        *(LAS u32x4*)(Cs + row * 136 + cseg) = rC0; *(LAS u32x4*)(Cs + row * 136 + cseg + 64) = rC1;
        *(LAS u32x4*)(Bs + row * 136 + cseg) = rB0; *(LAS u32x4*)(Bs + row * 136 + cseg + 64) = rB1;
        { const unsigned wds[8] = {rB0.x, rB0.y, rB0.z, rB0.w, rB1.x, rB1.y, rB1.z, rB1.w};
#pragma unroll
          for (int q = 0; q < 8; ++q) { const int n = cseg + (q >> 2) * 64 + (q & 3) * 2; BT[n * 72 + row] = (bf16)(wds[q] & 0xffffu); BT[(n + 1) * 72 + row] = (bf16)(wds[q] >> 16); } }
        if (wave == 0) {
            const float dt = softplus_f(rdt + dtb); float cs = dt * a_h;
#pragma unroll
            for (int off = 1; off < 64; off <<= 1) { const float v = __shfl_up(cs, off); if (lane >= off) cs += v; }
            const float tot = __shfl(cs, 63);
            csv[lane] = cs; dtv[lane] = dt; wv[lane] = dt * __expf(tot - cs);
        }
        __syncthreads();
        { float x[8]; unpack8(rX, x); const float wr_ = wv[row];
#pragma unroll
          for (int e = 0; e < 8; ++e) { XT[(cseg + e) * 72 + row] = (bf16)f2bf(x[e]); XwT[(cseg + e) * 72 + row] = (bf16)f2bf(x[e] * wr_); } }
        __syncthreads();
        if (c + 1 < 64) { const size_t o = (size_t)(tok0 + 64 + row) * PROJ_LD + cseg; rB0 = *(const u32x4*)(pB + o); rB1 = *(const u32x4*)(pB + o + 64); rC0 = *(const u32x4*)(pC + o); rC1 = *(const u32x4*)(pC + o + 64); rX = *(const u32x4*)(pX + o);
            if (wave == 0) rdt = dtp[(size_t)(tok0 + 64 + lane) * 16]; }
        const int lt = wave >> 1; f32x4 yacc[2];
#pragma unroll
        for (int q = 0; q < 2; ++q) { const int st = 2 * (wave & 1) + q;
            f32x4 G = mma_lds<128>((f32x4){0.f, 0.f, 0.f, 0.f}, Cs, 136, 16 * lt, Bs, 136, 16 * st, j, g);
            const int s = 16 * st + j; const float css = csv[s], dts = dtv[s];
#pragma unroll
            for (int r = 0; r < 4; ++r) { const int l = 16 * lt + 4 * g + r; const float dd = csv[l] - css; const float val = (s <= l) ? G[r] * __expf(fminf(dd, 0.f)) * dts : 0.f; Ms[l * 72 + s] = (bf16)f2bf(val); }
            f32x4 yo = mma_lds<128>((f32x4){0.f, 0.f, 0.f, 0.f}, Cs, 136, 16 * lt, Ss, 136, 16 * st, j, g);
#pragma unroll
            for (int r = 0; r < 4; ++r) yo[r] *= __expf(csv[16 * lt + 4 * g + r]);
            yacc[q] = yo; }
        __syncthreads();
        float sq[4] = {0.f, 0.f, 0.f, 0.f};
#pragma unroll
        for (int q = 0; q < 2; ++q) { const int pt = 2 * (wave & 1) + q; yacc[q] = mma_lds<64>(yacc[q], Ms, 72, 16 * lt, XT, 72, 16 * pt, j, g);
            const int p = 16 * pt + j;
#pragma unroll
            for (int r = 0; r < 4; ++r) { const int l = 16 * lt + 4 * g + r; const float x = bf2f(XT[p * 72 + l]); const float y = yacc[q][r] + Dh * x;
                bf16* zp = pZ + (size_t)(tok0 + l) * PROJ_LD + p; const float z = bf2f(*zp); const float v = y * pg8::fast_silu(z); *zp = (bf16)f2bf(v); sq[r] += v * v; } }
#pragma unroll
        for (int r = 0; r < 4; ++r) { float s = sq[r]; s += __shfl_xor(s, 1); s += __shfl_xor(s, 2); s += __shfl_xor(s, 4); s += __shfl_xor(s, 8);
            if (j == 0) ssq[(size_t)(tok0 + 16 * lt + 4 * g + r) * 32] = s; }
        const float dec = __expf(csv[63]);
#pragma unroll
        for (int pt = 0; pt < 4; ++pt) { sacc[pt] = sacc[pt] * dec; sacc[pt] = mma_lds<64>(sacc[pt], XwT, 72, 16 * pt, BT, 72, 16 * wave, j, g);
#pragma unroll
            for (int r = 0; r < 4; ++r) Ss[(16 * pt + 4 * g + r) * 136 + 16 * wave + j] = (bf16)f2bf(sacc[pt][r]); }
        __syncthreads();
    }
}
__device__ __forceinline__ void ssdnorm_phase(Ctx& F, int li, const float* p_nw) {
    bf16* proj = (bf16*)(F.ws + WS_PROJ); const float* ssq = (const float*)(F.ws + WS_SSQ);
    const int gw = F.bid * NWAVES + F.wave, NGW = F.G * NWAVES, lane = F.lane;
    float nw[16];
#pragma unroll
    for (int e = 0; e < 16; ++e) nw[e] = p_nw[li * 1024 + 16 * lane + e];
    for (int m = gw; m < M; m += NGW) {
        float ssum = 0.f; { const f32x4* sp = (const f32x4*)(ssq + (size_t)m * 32 + (lane >> 5) * 16); const f32x4 s0 = sp[0], s1 = sp[1], s2 = sp[2], s3 = sp[3];
          ssum = ((s0.x + s0.y) + (s0.z + s0.w)) + ((s1.x + s1.y) + (s1.z + s1.w)) + ((s2.x + s2.y) + (s2.z + s2.w)) + ((s3.x + s3.y) + (s3.z + s3.w)); }
        const float sc = 1.0f / sqrtf(ssum * (1.f / 512.f) + EPS);
        bf16* p = proj + (size_t)m * PROJ_LD + C_Z + 16 * lane; float x[16];
        unpack8(*(const u32x4*)p, x); unpack8(*(const u32x4*)(p + 8), x + 8);
#pragma unroll
        for (int e = 0; e < 16; ++e) x[e] = x[e] * sc * nw[e];
        *(u32x4*)p = pack8(x); *(u32x4*)(p + 8) = pack8(x + 8);
    }
}
__device__ __forceinline__ void qknorm_phase(Ctx& F, int li, const float* p_qn, const float* p_kn) {
    bf16* qkv = (bf16*)(F.ws + WS_PROJ);
    const int gt = F.bid * NTHREADS + F.tid, NT = F.G * NTHREADS;
    const float L2T = 18.931568569324174f;
    for (int idx = gt; idx < M * 32; idx += NT) {
        const int m = idx >> 5, qk = (idx >> 4) & 1, h = idx & 15;
        bf16* p = qkv + (size_t)m * QKV_LD + qk * 1024 + h * 64;
        const float* gain = (qk ? p_kn : p_qn) + li * 64;
        float x[64]; float ss = 0.f;
#pragma unroll
        for (int q = 0; q < 8; ++q) unpack8(*(const u32x4*)(p + 8 * q), x + 8 * q);
#pragma unroll
        for (int e = 0; e < 64; ++e) ss += x[e] * x[e];
        const float rs = 1.0f / sqrtf(ss * (1.f / 64.f) + EPS);
#pragma unroll
        for (int e = 0; e < 64; ++e) x[e] = x[e] * rs * gain[e];
        const float pos = (float)(m & (SEQ - 1));
#pragma unroll
        for (int i = 0; i < 8; ++i) { const float inv = exp2f(-(float)i * 0.125f * L2T); const float ang = pos * inv;
            double rev = (double)ang * 0.15915494309189535; rev -= floor(rev); const float fr = (float)rev;
            const float sn = __builtin_amdgcn_sinf(fr), cs = __builtin_amdgcn_cosf(fr);
            const float x1 = x[i], x2 = x[i + 8]; x[i] = x1 * cs - x2 * sn; x[i + 8] = x2 * cs + x1 * sn; }
        const float sc = qk ? 1.0f : 0.125f * 1.4426950408889634f;
#pragma unroll
        for (int q = 0; q < 8; ++q) { float y[8];
#pragma unroll
            for (int e = 0; e < 8; ++e) y[e] = x[8 * q + e] * sc;
            *(u32x4*)(p + 8 * q) = pack8(y); }
    }
}
template <int NQT, int MODE>
__device__ __forceinline__ void attn_run(const bf16* Qp, const bf16* Kp, const bf16* Vp, bf16* Op, int d, int r, int qs, int qloc0,
                                         LAS bf16* Vt, LAS float* Oacc, LAS float* Mb, LAS float* Lb, int lane) {
    const int j = lane & 15, g = lane >> 4;
    bf16x8 qf[NQT][2];
#pragma unroll
    for (int qt = 0; qt < NQT; ++qt) { const bf16* qp = Qp + (size_t)(r + d * (qs + 16 * qt + j)) * QKV_LD + 8 * g; qf[qt][0] = *(const bf16x8*)qp; qf[qt][1] = *(const bf16x8*)(qp + 32); }
    f32x4 o[NQT][4]; float mrun[NQT], lrun[NQT];
#pragma unroll
    for (int qt = 0; qt < NQT; ++qt) { mrun[qt] = -1e30f; lrun[qt] = 0.f;
#pragma unroll
        for (int dt = 0; dt < 4; ++dt) o[qt][dt] = (f32x4){0.f, 0.f, 0.f, 0.f}; }
    const int kstart = qs + 16 * NQT - 160;
    for (int ci = 0; ci < 5; ++ci) {
        const int kc = kstart + 32 * ci;
        bf16x8 kf[2][2];
#pragma unroll
        for (int tt = 0; tt < 2; ++tt) { int kidx = kc + 8 * (j >> 2) + 4 * tt + (j & 3); kidx = kidx < 0 ? 0 : kidx;
            const bf16* kp = Kp + (size_t)(r + d * kidx) * QKV_LD + 8 * g; kf[tt][0] = *(const bf16x8*)kp; kf[tt][1] = *(const bf16x8*)(kp + 32); }
        { int kv = kc + (lane >> 1); kv = kv < 0 ? 0 : kv; const bf16* vp = Vp + (size_t)(r + d * kv) * QKV_LD + (lane & 1) * 32;
          u32x4 v4[4];
#pragma unroll
          for (int q4 = 0; q4 < 4; ++q4) v4[q4] = *(const u32x4*)(vp + 8 * q4);
          LDS_FENCE();
#pragma unroll
          for (int q4 = 0; q4 < 4; ++q4) { const unsigned wds[4] = {v4[q4].x, v4[q4].y, v4[q4].z, v4[q4].w};
#pragma unroll
              for (int e = 0; e < 4; ++e) { const int dim = (lane & 1) * 32 + 8 * q4 + 2 * e; Vt[dim * 40 + (lane >> 1)] = (bf16)(wds[e] & 0xffffu); Vt[(dim + 1) * 40 + (lane >> 1)] = (bf16)(wds[e] >> 16); } } }
        LDS_FENCE();
        bf16x8 vf[4];
#pragma unroll
        for (int dt = 0; dt < 4; ++dt) vf[dt] = *(const LAS bf16x8*)(Vt + (16 * dt + j) * 40 + 8 * g);
#pragma unroll
        for (int qt = 0; qt < NQT; ++qt) {
            f32x4 s0 = (f32x4){0.f, 0.f, 0.f, 0.f}, s1 = (f32x4){0.f, 0.f, 0.f, 0.f};
            s0 = MFMA16(kf[0][0], qf[qt][0], s0); s0 = MFMA16(kf[0][1], qf[qt][1], s0);
            s1 = MFMA16(kf[1][0], qf[qt][0], s1); s1 = MFMA16(kf[1][1], qf[qt][1], s1);
            float sv[8] = {s0[0], s0[1], s0[2], s0[3], s1[0], s1[1], s1[2], s1[3]};
            const int qi = qs + 16 * qt + j; float mx = -1e30f; bool ok[8];
#pragma unroll
            for (int e = 0; e < 8; ++e) { const int kidx = kc + 8 * g + e; const int diff = qi - kidx; ok[e] = (kidx >= 0) && (diff >= 0) && (diff <= 128); mx = ok[e] ? fmaxf(mx, sv[e]) : mx; }
            mx = fmaxf(mx, __shfl_xor(mx, 16)); mx = fmaxf(mx, __shfl_xor(mx, 32));
            const float mnew = fmaxf(mrun[qt], mx); const float alpha = __builtin_amdgcn_exp2f(mrun[qt] - mnew); mrun[qt] = mnew;
            float pp[8], psum = 0.f;
#pragma unroll
            for (int e = 0; e < 8; ++e) { pp[e] = ok[e] ? __builtin_amdgcn_exp2f(sv[e] - mnew) : 0.f; psum += pp[e]; }
            lrun[qt] = lrun[qt] * alpha + psum;
            const u32x4 pw = pack8(pp); const bf16x8 pf = __builtin_bit_cast(bf16x8, pw);
#pragma unroll
            for (int dt = 0; dt < 4; ++dt) { o[qt][dt] = o[qt][dt] * alpha; o[qt][dt] = MFMA16(vf[dt], pf, o[qt][dt]); }
        }
    }
#pragma unroll
    for (int qt = 0; qt < NQT; ++qt) {
        float l = lrun[qt]; l += __shfl_xor(l, 16); l += __shfl_xor(l, 32);
        const float m = mrun[qt]; const int qloc = qloc0 + d * (16 * qt + j);
        if (MODE == 0) {
#pragma unroll
            for (int dt = 0; dt < 4; ++dt)
#pragma unroll
                for (int rr = 0; rr < 4; ++rr) Oacc[qloc * 65 + 16 * dt + 4 * g + rr] = o[qt][dt][rr];
            if (g == 0) { Mb[qloc] = m; Lb[qloc] = l; }
        } else {
            const float mo = Mb[qloc], lo = Lb[qloc]; const float mn = fmaxf(mo, m);
            const float fo = __builtin_amdgcn_exp2f(mo - mn), fn = __builtin_amdgcn_exp2f(m - mn); const float ln = lo * fo + l * fn;
            LDS_FENCE();
            if (MODE == 1) {
#pragma unroll
                for (int dt = 0; dt < 4; ++dt)
#pragma unroll
                    for (int rr = 0; rr < 4; ++rr) { const int ix = qloc * 65 + 16 * dt + 4 * g + rr; Oacc[ix] = Oacc[ix] * fo + o[qt][dt][rr] * fn; }
                if (g == 0) { Mb[qloc] = mn; Lb[qloc] = ln; }
            } else {
                const float inv = 1.0f / ln; bf16* op = Op + (size_t)(r + d * (qs + 16 * qt + j)) * DM;
#pragma unroll
                for (int dt = 0; dt < 4; ++dt) { float y[4];
#pragma unroll
                    for (int rr = 0; rr < 4; ++rr) { const int ix = qloc * 65 + 16 * dt + 4 * g + rr; y[rr] = (Oacc[ix] * fo + o[qt][dt][rr] * fn) * inv; }
                    u32x2 w; w.x = pk2(y[0], y[1]); w.y = pk2(y[2], y[3]); *(u32x2*)(op + 16 * dt + 4 * g) = w; }
            }
        }
    }
    LDS_FENCE();
}
__device__ __forceinline__ void attn_item(Ctx& F, int b, int h, int blk) {
    bf16* base = (bf16*)(F.ws + WS_PROJ) + (size_t)b * SEQ * QKV_LD + h * 64;
    const bf16* Qp = base; const bf16* Kp = base + 1024; const bf16* Vp = base + 2048;
    const int wave = F.wave, lane = F.lane, T0 = blk * 256;
    bf16* Ob = (bf16*)(F.ws + WS_H) + (size_t)b * SEQ * DM + h * 64;
    LAS bf16* Vt = (LAS bf16*)(F.lds + wave * 5120);
    LAS float* Oacc = (LAS float*)(F.lds + 40960); LAS float* Mb = Oacc + 256 * 65; LAS float* Lb = Mb + 256;
    attn_run<2, 0>(Qp, Kp, Vp, Ob, 1, 0, T0 + 32 * wave, 32 * wave, Vt, Oacc, Mb, Lb, lane);
    __syncthreads();
    attn_run<2, 1>(Qp, Kp, Vp, Ob, 4, wave >> 1, T0 / 4 + 32 * (wave & 1), (wave >> 1) + 128 * (wave & 1), Vt, Oacc, Mb, Lb, lane);
    __syncthreads();
    for (int cc = 0; cc < 2; ++cc) attn_run<1, 2>(Qp, Kp, Vp, Ob, 16, 2 * wave + cc, T0 / 16, 2 * wave + cc, Vt, Oacc, Mb, Lb, lane);
    __syncthreads();
}
struct Args { const float* in[25]; float* out; unsigned char* ws; int ph_lo, ph_hi; };
static_assert(sizeof(Args) == 224, "Args layout");
#ifndef PG8_SP2
#define PG8_SP2 true
#endif
#ifndef PG8_ALIGN
#define PG8_ALIGN true
#endif
__device__ __forceinline__ void gemm_proj(Ctx& F, const bf16* A, int lda, const bf16* Bt, int N, int K, bf16* O, int ldc, float* dt, int dt_pn) {
    pg8::Gemm g{A, Bt, M, N, K, lda}; pg8::StaticOrder S; S.init(M, N, F.G, F.bid);
    pg8::EpiProj E{O, ldc, dt, dt_pn};
    pg8::gemm_phase<pg8::EpiProj, pg8::StaticOrder, PG8_ALIGN, PG8_SP2>(F.lds, g, S, E, F.tid);
}
__device__ __forceinline__ void gemm_swiglu(Ctx& F, const bf16* A, const bf16* Bt, bf16* O) {
    pg8::Gemm g{A, Bt, M, GU_N, DM, DM}; pg8::StaticOrder S; S.init(M, GU_N, F.G, F.bid);
    pg8::EpiSwiglu E{O, FFN_H};
    pg8::gemm_phase<pg8::EpiSwiglu, pg8::StaticOrder, PG8_ALIGN, PG8_SP2>(F.lds, g, S, E, F.tid);
}
__device__ __forceinline__ void gemm_res(Ctx& F, const bf16* A, int lda, const bf16* Bt, int K, const float* base, float* out) {
    pg8::Gemm g{A, Bt, M, DM, K, lda}; pg8::StaticOrder S; S.init(M, DM, F.G, F.bid);
    pg8::EpiRes E{base, out, DM};
    pg8::gemm_phase<pg8::EpiRes, pg8::StaticOrder, PG8_ALIGN, PG8_SP2>(F.lds, g, S, E, F.tid);
}

__global__ void __launch_bounds__(NTHREADS, 2) trunk_fwd(Args args) {
    extern __shared__ __attribute__((aligned(16))) unsigned char lds_raw[];
    cg::grid_group grid = cg::this_grid();
    Ctx F;
    F.lds = (LAS unsigned char*)lds_raw; F.tid = threadIdx.x; F.lane = F.tid & 63; F.wave = __builtin_amdgcn_readfirstlane(F.tid >> 6); F.G = gridDim.x; F.bid = blockIdx.x;
#define Hb ((bf16*)(F.ws + WS_H))
#define PJ ((bf16*)(F.ws + WS_PROJ))
#define KAS __attribute__((address_space(4)))
#define KIN(k) (*(const float* KAS const*)(karg + 8 * (k)))
    KAS unsigned char* karg0 = (KAS unsigned char*)__builtin_amdgcn_kernarg_segment_ptr();
    const int lo = *(KAS const int*)(karg0 + 216), hi = *(KAS const int*)(karg0 + 220); int ph = 0;
#define PHASE_BEGIN if (ph >= lo && ph < hi) { KAS unsigned char* karg = karg0; { int t_ = threadIdx.x, b_ = blockIdx.x, g_ = gridDim.x; asm volatile("" : "+s"(karg), "+v"(t_), "+s"(b_), "+s"(g_)); F.ws = *(unsigned char* KAS const*)(karg + 208); F.out = *(float* KAS const*)(karg + 200); F.tid = t_; F.lane = t_ & 63; F.wave = __builtin_amdgcn_readfirstlane(t_ >> 6); F.bid = b_; F.G = g_; }
#define PHASE_END if (ph + 1 < hi) { asm volatile("s_waitcnt vmcnt(0) lgkmcnt(0)" ::: "memory"); grid.sync(); __builtin_amdgcn_fence(__ATOMIC_ACQUIRE, "agent"); asm volatile("s_waitcnt vmcnt(0)" ::: "memory"); __syncthreads(); } } ++ph;

    PHASE_BEGIN p0_weights(F, KIN(2), KIN(16), KIN(18), KIN(21), KIN(23), KIN(24), KIN(5), KIN(7)); PHASE_END
#pragma unroll 1
    for (int layer = 0; layer < DEPTH; ++layer) {
        const int li = layer >> 1;

        if ((layer & 1) == 0) {
            PHASE_BEGIN
                norm_phase(F, (layer == 0) ? KIN(0) : F.out, KIN(1) + li * DM, Hb);
            PHASE_END
            PHASE_BEGIN
                gemm_proj(F, Hb, DM, (const bf16*)(F.ws + W_REC_IN + li * SZ_REC_IN), PROJ_LD, DM, PJ, PROJ_LD, (float*)(F.ws + WS_DT), 18);
            PHASE_END
            PHASE_BEGIN halo_phase(F); PHASE_END
            PHASE_BEGIN conv_phase(F, li, KIN(3), KIN(4), KIN(10), KIN(11)); PHASE_END
            PHASE_BEGIN
                for (int it = F.bid; it < 256; it += F.G) { if (it < 128) ssd_item(F, li, it >> 4, it & 15, KIN(12), KIN(13), KIN(14)); else lru_item(F, li, (it - 128) >> 4, (it - 128) & 15, KIN(6), KIN(8), KIN(9)); __syncthreads(); }
            PHASE_END
            PHASE_BEGIN ssdnorm_phase(F, li, KIN(15)); PHASE_END
            PHASE_BEGIN
                gemm_res(F, PJ + C_GATE, PROJ_LD, (const bf16*)(F.ws + W_REC_OUT + li * SZ_REC_OUT), REC_OUT, (layer == 0) ? KIN(0) : F.out, F.out);
            PHASE_END
        } else {
            PHASE_BEGIN norm_phase(F, F.out, KIN(17) + li * DM, Hb); PHASE_END
            PHASE_BEGIN gemm_proj(F, Hb, DM, (const bf16*)(F.ws + W_QKV + li * SZ_QKV), QKV_LD, DM, PJ, QKV_LD, nullptr, -1); PHASE_END
            PHASE_BEGIN qknorm_phase(F, li, KIN(19), KIN(20)); PHASE_END
            PHASE_BEGIN
                for (int it = F.bid; it < BATCH * 16 * 16; it += F.G) attn_item(F, it >> 8, (it >> 4) & 15, it & 15);
            PHASE_END
            PHASE_BEGIN gemm_res(F, Hb, DM, (const bf16*)(F.ws + W_ATT_OUT + li * SZ_ATT_OUT), DM, F.out, F.out); PHASE_END
        }
        PHASE_BEGIN norm_phase(F, F.out, KIN(22) + layer * DM, Hb); PHASE_END
        PHASE_BEGIN gemm_swiglu(F, Hb, (const bf16*)(F.ws + W_GU + layer * SZ_GU), PJ); PHASE_END
        PHASE_BEGIN gemm_res(F, PJ, FFN_H, (const bf16*)(F.ws + W_DOWN + layer * SZ_DOWN), FFN_H, F.out, F.out); PHASE_END
    }
}
constexpr int N_PHASES = 1 + 2 * 10 + 2 * 8;

extern "C" void kernel_launch(void* const* d_in, const int* in_sizes, int n_in, void* d_out, int out_size, void* d_ws, size_t ws_size, hipStream_t stream) {
    static int grid = 0;
    if (grid == 0) {
        if (n_in != 25 || in_sizes[0] != M * DM || out_size != M * DM || ws_size < WS_END) { fprintf(stderr, "kernel_launch: unexpected shapes (n_in %d, in0 %d, out %d, ws %zu)\n", n_in, n_in > 0 ? in_sizes[0] : -1, out_size, ws_size); grid = -1; return; }
        int dev = 0, cus = 0, per_cu = 0;
        (void)hipGetDevice(&dev); (void)hipDeviceGetAttribute(&cus, hipDeviceAttributeMultiprocessorCount, dev);
        if (hipFuncSetAttribute((const void*)trunk_fwd, hipFuncAttributeMaxDynamicSharedMemorySize, LDS_BYTES) != hipSuccess) { fprintf(stderr, "kernel_launch: hipFuncSetAttribute failed\n"); grid = -1; return; }
        if (hipOccupancyMaxActiveBlocksPerMultiprocessor(&per_cu, (const void*)trunk_fwd, NTHREADS, LDS_BYTES) != hipSuccess || per_cu < 1) { fprintf(stderr, "kernel_launch: occupancy query says %d\n", per_cu); per_cu = 1; }
        (void)hipGetLastError();
        grid = cus * 1;
        fprintf(stderr, "kernel_launch: grid %d (cus %d, per_cu %d)\n", grid, cus, per_cu);
    }
    if (grid < 0) return;
    Args a{};
    for (int i = 0; i < 25; ++i) a.in[i] = (const float*)d_in[i];
    a.out = (float*)d_out; a.ws = (unsigned char*)d_ws; a.ph_lo = 0; a.ph_hi = N_PHASES;
    void* kargs[] = {&a};
    hipError_t e = hipLaunchCooperativeKernel((const void*)trunk_fwd, dim3(grid), dim3(NTHREADS), kargs, LDS_BYTES, stream);
    if (e != hipSuccess) fprintf(stderr, "kernel_launch: cooperative launch failed: %s (grid %d)\n", hipGetErrorString(e), grid);
}
```

```cpp
#include <hip/hip_runtime.h>
#include <hip/hip_cooperative_groups.h>
#include <cstdio>
#include <cstdint>
namespace cg = cooperative_groups;
namespace pg8 {
#define PG8_LAS __attribute__((address_space(3)))
typedef unsigned short bf16_t;
typedef short bf16x8 __attribute__((ext_vector_type(8)));
typedef float f32x4 __attribute__((ext_vector_type(4)));
typedef unsigned u32x4 __attribute__((ext_vector_type(4)));
constexpr int BM = 256, BK = 64, HALF = 128, HTB = HALF * BK * 2  , STAGE_BYTES = 8 * HTB, NXCD = 8, WGM = 8;

__host__ __device__ __forceinline__ int lds_byte(int r, int c) { const int st = (r >> 4) * 2 + (c >> 5), rr = r & 15, cc = c & 31, ob = rr * 64 + cc * 2; return st * 1024 + (ob ^ (((ob >> 9) & 1) << 5)); }
__host__ __device__ __forceinline__ void stage_rc(int b, int& R, int& C) { const int st = b / 1024, sb = b % 1024, swz = sb ^ (((sb >> 9) & 1) << 5); R = (st >> 1) * 16 + swz / 64; C = (st & 1) * 32 + (swz % 64) / 2; }
__host__ __device__ __forceinline__ int perm32(int rho) { const int n = rho >> 4, i = rho & 15; return 8 * (i >> 2) + 4 * n + (i & 3); }

struct Unit { int pm, pn; };
struct Gemm { const bf16_t* A; const bf16_t* Bt; int M, N, K, lda; };

struct StaticOrder {
    int nM, nN, nwg, G, c;
    __host__ __device__ void init(int M, int N, int G_, int c_) { nM = M / BM; nN = N / BM; nwg = nM * nN; G = G_; c = c_; }
    __host__ __device__ bool next(int i, Unit& u) const {
        const long L = (long)i * G + c; if (L >= nwg) return false;
        int wgid = (int)L; { const int q = nwg / NXCD, r = nwg % NXCD, xcd = wgid % NXCD, off = wgid / NXCD; wgid = (xcd < r ? xcd * (q + 1) : r * (q + 1) + (xcd - r) * q) + off; }
        const int nig = WGM * nN, gid = wgid / nig, fm = gid * WGM, gsz = (nM - fm) < WGM ? (nM - fm) : WGM;
        u.pm = fm + ((wgid % nig) % gsz); u.pn = (wgid % nig) / gsz; return true;
    }
    __device__ __forceinline__ void a_ready(const Unit&) const {}
    __device__ __forceinline__ void done(const Unit&) const {}
};

__device__ __forceinline__ unsigned cvt_pk_bf16(float lo, float hi) { unsigned r; asm volatile("v_cvt_pk_bf16_f32 %0, %1, %2" : "=v"(r) : "v"(lo), "v"(hi)); return r; }
typedef float f32x2 __attribute__((ext_vector_type(2)));
__device__ __forceinline__ float fast_exp(float x) { return __builtin_amdgcn_exp2f(x * 1.4426950408889634f); }
__device__ __forceinline__ float fast_sigmoid(float x) { return __builtin_amdgcn_rcpf(1.0f + fast_exp(-x)); }
__device__ __forceinline__ float fast_silu(float x) { return x * fast_sigmoid(x); }

__device__ __forceinline__ float row_rs(const float* rs, int row) {
    const f32x4* p = (const f32x4*)(rs + (size_t)row * 16); const f32x4 a = p[0], b = p[1], c = p[2], d = p[3];
    const float s = ((a[0] + a[1]) + (a[2] + a[3])) + ((b[0] + b[1]) + (b[2] + b[3])) + ((c[0] + c[1]) + (c[2] + c[3])) + ((d[0] + d[1]) + (d[2] + d[3]));
    return 1.0f / sqrtf(s * (1.0f / 1024.0f) + 1e-6f);
}
struct RsView { const PG8_LAS float* p; bool hit; };
__device__ __forceinline__ RsView rs_view(PG8_LAS unsigned char* ldsx, int pm) {
    const PG8_LAS int* pmt = (const PG8_LAS int*)(ldsx + 4096); const PG8_LAS float* t = (const PG8_LAS float*)ldsx; RsView v; v.hit = true;
    if (pmt[0] == pm) v.p = t; else if (pmt[1] == pm) v.p = t + 256; else if (pmt[2] == pm) v.p = t + 512; else if (pmt[3] == pm) v.p = t + 768; else { v.p = t; v.hit = false; }
    return v;
}
#define RS_GET(view, rs, row) ((view).hit ? (view).p[(row) & 255] : row_rs((rs), (row)))
typedef unsigned u32x2v __attribute__((ext_vector_type(2)));
__device__ __forceinline__ float gelu_tanh_e(float x) { const float y = 0.7978845608028654f * (x + 0.044715f * x * x * x); const float e = fast_exp(2.f * y); const float t = 1.f - 2.f * __builtin_amdgcn_rcpf(e + 1.f); return 0.5f * x * (1.f + t); }
struct EpiProj {
    static constexpr bool PERM = true, AFTER_DRAIN = false;
    PG8_LAS unsigned char* ldsx; bf16_t* O; int ldc; float* dt; int dt_pn; const float* rs; bf16_t* halo;
    __device__ __forceinline__ void operator()(const f32x4 (&acc)[2][2][4][2], const Unit& u, int wr, int wc, int fr, int fq) const {
        const int row0 = u.pm * BM + wr * 64 + fr; const int col0 = u.pn * BM + wc * 32 + 8 * fq; const RsView rv = rs_view(ldsx, u.pm);
#pragma unroll
        for (int ai = 0; ai < 2; ++ai)
#pragma unroll
            for (int m = 0; m < 4; ++m) { const int row = row0 + ai * HALF + m * 16; bf16_t* rowp = O + (size_t)row * ldc + col0; const float sc = RS_GET(rv, rs, row);
#pragma unroll
                for (int bj = 0; bj < 2; ++bj) { f32x4 v0 = acc[ai][bj][m][0] * sc, v1 = acc[ai][bj][m][1] * sc;
                    if (dt) { const int cblk = (col0 + bj * HALF) >> 10;
                        if (cblk == 1) {
#pragma unroll
                            for (int e = 0; e < 4; ++e) { v0[e] = gelu_tanh_e(v0[e]); v1[e] = gelu_tanh_e(v1[e]); } }
                        else if (cblk == 2) {
#pragma unroll
                            for (int e = 0; e < 4; ++e) { v0[e] = fast_silu(v0[e]); v1[e] = fast_silu(v1[e]); } } }
                    u32x4 w; w.x = cvt_pk_bf16(v0[0], v0[1]); w.y = cvt_pk_bf16(v0[2], v0[3]); w.z = cvt_pk_bf16(v1[0], v1[1]); w.w = cvt_pk_bf16(v1[2], v1[3]);
                    *(u32x4*)(rowp + bj * HALF) = w;
                    if (halo && m == 3 && fr >= 13) { const int col = col0 + bj * HALF; const int t = row & 4095;
                        if (t < 4032 && (col < 1024 || (col >= 3072 && col < 4608))) { const int gidx = col < 1024 ? (col >> 3) : 128 + ((col - 3072) >> 3);
                            *(u32x4*)(halo + (size_t)(((row >> 12) * 64 + (t >> 6) + 1) * 3 + (fr - 13)) * 2560 + gidx * 8) = w; } } }
                if (u.pn == dt_pn && wc == 0 && fq < 2) { float* dp = dt + (size_t)row * 16 + 8 * fq; *(f32x4*)dp = acc[ai][0][m][0] * sc; *(f32x4*)(dp + 4) = acc[ai][0][m][1] * sc; } }
    }
};

struct EpiQKV {
    static constexpr bool PERM = true, AFTER_DRAIN = false;
    PG8_LAS unsigned char* ldsx; bf16_t* O; int ldc; const float* rs; const float* gq; const float* gk;
    __device__ __forceinline__ void operator()(const f32x4 (&acc)[2][2][4][2], const Unit& u, int wr, int wc, int fr, int fq) const {
        const int row0 = u.pm * BM + wr * 64 + fr; const RsView rv = rs_view(ldsx, u.pm);
        if (u.pn >= 8) {
            const int col0 = u.pn * BM + wc * 32 + 8 * fq;
#pragma unroll
            for (int ai = 0; ai < 2; ++ai)
#pragma unroll
                for (int m = 0; m < 4; ++m) { const int row = row0 + ai * HALF + m * 16; bf16_t* rowp = O + (size_t)row * ldc + col0; const float sc = RS_GET(rv, rs, row);
#pragma unroll
                    for (int bj = 0; bj < 2; ++bj) { const f32x4 v0 = acc[ai][bj][m][0] * sc, v1 = acc[ai][bj][m][1] * sc;
                        u32x4 w; w.x = cvt_pk_bf16(v0[0], v0[1]); w.y = cvt_pk_bf16(v0[2], v0[3]); w.z = cvt_pk_bf16(v1[0], v1[1]); w.w = cvt_pk_bf16(v1[2], v1[3]);
                        *(u32x4*)(rowp + bj * HALF) = w; } }
            return;
        }
        const int region = u.pn >> 2, head = 4 * (u.pn & 3) + wc; const float* gain = region ? gk : gq;
        const float oscale = region ? 1.0f : 0.125f * 1.4426950408889634f;
        const bool rot = fq < 2;
        f32x4 gv[2][2];
#pragma unroll
        for (int bj = 0; bj < 2; ++bj)
#pragma unroll
            for (int n = 0; n < 2; ++n) { const int dbase = (bj == 0 && rot) ? 4 * fq + 8 * n : 32 * bj + 8 * fq + 4 * n; gv[bj][n] = *(const f32x4*)(gain + dbase); }
        float inv[4];
#pragma unroll
        for (int e = 0; e < 4; ++e) inv[e] = exp2f(-(float)(4 * (fq & 1) + e) * 0.125f * 18.931568569324174f);
#pragma unroll
        for (int ai = 0; ai < 2; ++ai)
#pragma unroll
            for (int m = 0; m < 4; ++m) { const int row = row0 + ai * HALF + m * 16; const float sc = RS_GET(rv, rs, row);
                f32x4 v[2][2]; float ss = 0.f;
#pragma unroll
                for (int bj = 0; bj < 2; ++bj)
#pragma unroll
                    for (int n = 0; n < 2; ++n) { v[bj][n] = acc[ai][bj][m][n] * sc; ss += (v[bj][n][0] * v[bj][n][0] + v[bj][n][1] * v[bj][n][1]) + (v[bj][n][2] * v[bj][n][2] + v[bj][n][3] * v[bj][n][3]); }
                ss += __shfl_xor(ss, 16); ss += __shfl_xor(ss, 32);
                const float rn = 1.0f / sqrtf(ss * (1.0f / 64.0f) + 1e-6f);
#pragma unroll
                for (int bj = 0; bj < 2; ++bj)
#pragma unroll
                    for (int n = 0; n < 2; ++n) v[bj][n] = v[bj][n] * rn * gv[bj][n];
                if (rot) { const float pos = (float)(row & 4095);
#pragma unroll
                    for (int e = 0; e < 4; ++e) { const float ang = pos * inv[e]; double rev = (double)ang * 0.15915494309189535; rev -= floor(rev); const float frv = (float)rev;
                        const float sn = __builtin_amdgcn_sinf(frv), cs = __builtin_amdgcn_cosf(frv); const float x1 = v[0][0][e], x2 = v[0][1][e];
                        v[0][0][e] = x1 * cs - x2 * sn; v[0][1][e] = x2 * cs + x1 * sn; } }
                bf16_t* rowp = O + (size_t)row * ldc + region * 1024 + head * 64 + 8 * fq;
#pragma unroll
                for (int bj = 0; bj < 2; ++bj) { const f32x4 v0 = v[bj][0] * oscale, v1 = v[bj][1] * oscale;
                    u32x4 w; w.x = cvt_pk_bf16(v0[0], v0[1]); w.y = cvt_pk_bf16(v0[2], v0[3]); w.z = cvt_pk_bf16(v1[0], v1[1]); w.w = cvt_pk_bf16(v1[2], v1[3]);
                    *(u32x4*)(rowp + bj * 32) = w; } }
    }
};
struct EpiSwiglu {
    static constexpr bool PERM = true, AFTER_DRAIN = false;
    PG8_LAS unsigned char* ldsx; bf16_t* O; int ldc; const float* rs;
    __device__ __forceinline__ void operator()(const f32x4 (&acc)[2][2][4][2], const Unit& u, int wr, int wc, int fr, int fq) const {
        const int row0 = u.pm * BM + wr * 64 + fr; const int col0 = u.pn * HALF + wc * 32 + 8 * fq; const RsView rv = rs_view(ldsx, u.pm);
#pragma unroll
        for (int ai = 0; ai < 2; ++ai)
#pragma unroll
            for (int m = 0; m < 4; ++m) { bf16_t* rowp = O + (size_t)(row0 + ai * HALF + m * 16) * ldc + col0; const float sc = RS_GET(rv, rs, row0 + ai * HALF + m * 16);
                float o[8];
#pragma unroll
                for (int n = 0; n < 2; ++n)
#pragma unroll
                    for (int e = 0; e < 4; ++e) { const float gv = acc[ai][0][m][n][e] * sc, uv = acc[ai][1][m][n][e] * sc; o[n * 4 + e] = fast_silu(gv) * uv; }
                u32x4 w; w.x = cvt_pk_bf16(o[0], o[1]); w.y = cvt_pk_bf16(o[2], o[3]); w.z = cvt_pk_bf16(o[4], o[5]); w.w = cvt_pk_bf16(o[6], o[7]);
                *(u32x4*)rowp = w; }
    }
};
struct EpiRes {
    static constexpr bool PERM = false, AFTER_DRAIN = false;
    const float* basef; float* outf; int ldc; bf16_t* xb; float* rsout;
    __device__ __forceinline__ void operator()(const f32x4 (&acc)[2][2][4][2], const Unit& u, int wr, int wc, int fr, int fq) const {
        const int row0 = u.pm * BM + wr * 64 + fr; const int col0 = u.pn * BM + wc * 32 + 4 * fq;
#pragma unroll
        for (int ai = 0; ai < 2; ++ai)
#pragma unroll
            for (int m = 0; m < 4; ++m) { const int row = row0 + ai * HALF + m * 16; const size_t off = (size_t)row * ldc + col0; float ss = 0.f;
#pragma unroll
                for (int bj = 0; bj < 2; ++bj)
#pragma unroll
                    for (int n = 0; n < 2; ++n) { const size_t o = off + bj * HALF + n * 16; f32x4 bs;
                        if (basef) bs = *(const f32x4*)(basef + o);
                        else { const u32x2v w = *(const u32x2v*)(xb + o); bs = (f32x4){__builtin_bit_cast(float, w.x << 16), __builtin_bit_cast(float, w.x & 0xffff0000u), __builtin_bit_cast(float, w.y << 16), __builtin_bit_cast(float, w.y & 0xffff0000u)}; }
                        const f32x4 v = bs + acc[ai][bj][m][n];
                        if (outf) *(f32x4*)(outf + o) = v;
                        ss += (v[0] * v[0] + v[1] * v[1]) + (v[2] * v[2] + v[3] * v[3]);
                        u32x2v w2; w2.x = cvt_pk_bf16(v[0], v[1]); w2.y = cvt_pk_bf16(v[2], v[3]); *(u32x2v*)(xb + o) = w2; }
                ss += __shfl_xor(ss, 16); ss += __shfl_xor(ss, 32);
                if (fq == 0) rsout[(size_t)row * 16 + u.pn * 4 + wc] = ss; }
    }
};
template <class Epi, class Sched, bool ALIGN_EPI = false, bool SP2 = false>
__device__ __forceinline__ void gemm_phase(PG8_LAS unsigned char* lds, const Gemm g, const Sched& S, const Epi& E, const int tid) {
    const int wid = __builtin_amdgcn_readfirstlane(tid >> 6), lane = tid & 63, wr = wid >> 2, wc = wid & 3, fr = lane & 15, fq = lane >> 4;
    const int K = g.K, nt = K / BK;
    unsigned voffA[2], voffB[2];
#pragma unroll
    for (int i = 0; i < 2; ++i) { int R, C; stage_rc(tid * 16 + i * 8192, R, C); const int Rb = Epi::PERM ? ((R & ~31) + perm32(R & 31)) : R;
        voffA[i] = (unsigned)(R * g.lda + C) * 2u; voffB[i] = (unsigned)(Rb * K + C) * 2u; }
    const size_t kstep = (size_t)(BK * 2);
    const size_t hstepA = (size_t)HALF * g.lda * 2, hstepB = (size_t)HALF * K * 2;
    const size_t tstepA = 2 * hstepA, tstepB = 2 * hstepB;
    const unsigned ldsw = (unsigned)wid * 1024u;
    const int aoff = lds_byte(wr * 64 + fr, fq * 8), boff = lds_byte(wc * 32 + fr, fq * 8);
#define PG8_SA(b, h) (((b) * 2 + (h)) * HTB)
#define PG8_SB(b, h) ((4 + (b) * 2 + (h)) * HTB)
#define PG8_STAGE(bufoff, gbase, voff) do { _Pragma("unroll") for (int _i = 0; _i < 2; ++_i) \
        __builtin_amdgcn_global_load_lds((const unsigned*)((const char*)(gbase) + (voff)[_i]), (PG8_LAS unsigned*)(lds + (bufoff) + ldsw + _i * 8192), 16, 0, 0); } while (0)
#define PG8_LDA(dst, b, h) do { _Pragma("unroll") for (int m = 0; m < 4; ++m) _Pragma("unroll") for (int k = 0; k < 2; ++k) dst[m][k] = *(const PG8_LAS bf16x8*)(lds + PG8_SA(b, h) + aoff + m * 2048 + k * 1024); } while (0)
#define PG8_LDB(dst, b, h) do { _Pragma("unroll") for (int n = 0; n < 2; ++n) _Pragma("unroll") for (int k = 0; k < 2; ++k) dst[n][k] = *(const PG8_LAS bf16x8*)(lds + PG8_SB(b, h) + boff + n * 2048 + k * 1024); } while (0)
#define PG8_MMA(ai, bj, At, Bt) do { __builtin_amdgcn_s_setprio(1); _Pragma("unroll") for (int m = 0; m < 4; ++m) _Pragma("unroll") for (int n = 0; n < 2; ++n) _Pragma("unroll") for (int k = 0; k < 2; ++k) \
        acc[ai][bj][m][n] = __builtin_amdgcn_mfma_f32_16x16x32_bf16(Bt[n][k], At[m][k], acc[ai][bj][m][n], 0, 0, 0); __builtin_amdgcn_s_setprio(0); } while (0)
#define PG8_WAIT_V(n) asm volatile("s_waitcnt vmcnt(" #n ")" ::: "memory")
#define PG8_WAIT_L(n) asm volatile("s_waitcnt lgkmcnt(" #n ")" ::: "memory")
#define PG8_BAR __builtin_amdgcn_s_barrier()
#define PG8_SCHED __builtin_amdgcn_sched_barrier(0)
    Unit cur, nxt; int ui = 0;
    if (!S.next(0, cur)) return;
    f32x4 acc[2][2][4][2];
#pragma unroll
    for (int a = 0; a < 2; ++a)
#pragma unroll
        for (int b = 0; b < 2; ++b)
#pragma unroll
            for (int m = 0; m < 4; ++m)
#pragma unroll
                for (int n = 0; n < 2; ++n) acc[a][b][m][n] = (f32x4){0.f, 0.f, 0.f, 0.f};
    bf16x8 At[4][2], B0[2][2], B1[2][2];
    const char* cA = (const char*)g.A + (size_t)cur.pm * tstepA; const char* cB = (const char*)g.Bt + (size_t)cur.pn * tstepB;
    S.a_ready(cur);
    if constexpr (SP2) {
        PG8_STAGE(PG8_SB(0, 0), cB, voffB); PG8_STAGE(PG8_SB(0, 1), cB + hstepB, voffB); PG8_STAGE(PG8_SA(0, 0), cA, voffA); PG8_STAGE(PG8_SA(0, 1), cA + hstepA, voffA);
        if (wr == 1) PG8_BAR;
        PG8_WAIT_V(2); PG8_BAR;
        PG8_STAGE(PG8_SB(1, 0), cB + kstep, voffB); PG8_STAGE(PG8_SA(1, 0), cA + kstep, voffA); PG8_STAGE(PG8_SB(1, 1), cB + hstepB + kstep, voffB);
        PG8_WAIT_V(6); PG8_BAR;
    } else {
        PG8_STAGE(PG8_SB(0, 0), cB, voffB); PG8_STAGE(PG8_SA(0, 0), cA, voffA); PG8_STAGE(PG8_SB(0, 1), cB + hstepB, voffB); PG8_STAGE(PG8_SA(0, 1), cA + hstepA, voffA);
        if (wr == 1) PG8_BAR;
        PG8_WAIT_V(4); PG8_BAR;
        PG8_STAGE(PG8_SB(1, 0), cB + kstep, voffB); PG8_STAGE(PG8_SA(1, 0), cA + kstep, voffA); PG8_STAGE(PG8_SB(1, 1), cB + hstepB + kstep, voffB);
        PG8_WAIT_V(6); PG8_BAR;
    }
    for (;;) {
        const bool has_next = S.next(ui + 1, nxt);
        const char* nA = has_next ? (const char*)g.A + (size_t)nxt.pm * tstepA : cA; const char* nB = has_next ? (const char*)g.Bt + (size_t)nxt.pn * tstepB : cB;
        for (int t = 0; t < nt; t += 2) {
            const bool last = (t == nt - 2);
            const char* a1 = cA + (size_t)(t + 1) * kstep;
            const char* a2 = last ? nA : cA + (size_t)(t + 2) * kstep; const char* b2 = last ? nB : cB + (size_t)(t + 2) * kstep;
            const char* a3 = a2 + kstep; const char* b3 = b2 + kstep;
            if (last && has_next) S.a_ready(nxt);
            if constexpr (SP2) {
            PG8_LDB(B0, 0, 0); PG8_LDB(B1, 0, 1); PG8_SCHED; PG8_LDA(At, 0, 0); PG8_STAGE(PG8_SA(1, 1), a1 + hstepA, voffA);
            PG8_WAIT_V(8); PG8_WAIT_L(0); PG8_BAR; PG8_MMA(0, 0, At, B0); PG8_MMA(0, 1, At, B1); PG8_BAR; PG8_SCHED;
            PG8_LDA(At, 0, 1); PG8_STAGE(PG8_SB(0, 0), b2, voffB); PG8_STAGE(PG8_SB(0, 1), b2 + hstepB, voffB); PG8_STAGE(PG8_SA(0, 0), a2, voffA);
            PG8_WAIT_V(8); PG8_WAIT_L(0); PG8_BAR; PG8_MMA(1, 0, At, B0); PG8_MMA(1, 1, At, B1); PG8_BAR; PG8_SCHED;
            PG8_LDB(B0, 1, 0); PG8_LDB(B1, 1, 1); PG8_SCHED; PG8_LDA(At, 1, 0); PG8_STAGE(PG8_SA(0, 1), a2 + hstepA, voffA);
            PG8_WAIT_V(8); PG8_WAIT_L(0); PG8_BAR; PG8_MMA(0, 0, At, B0); PG8_MMA(0, 1, At, B1); PG8_BAR; PG8_SCHED;
            PG8_LDA(At, 1, 1); PG8_STAGE(PG8_SB(1, 0), b3, voffB); PG8_STAGE(PG8_SB(1, 1), b3 + hstepB, voffB); PG8_STAGE(PG8_SA(1, 0), a3, voffA);
            PG8_WAIT_V(8); PG8_WAIT_L(0); PG8_BAR; PG8_MMA(1, 0, At, B0); PG8_MMA(1, 1, At, B1); PG8_BAR; PG8_SCHED;
            } else {
            PG8_LDB(B0, 0, 0); PG8_SCHED; PG8_LDA(At, 0, 0); PG8_STAGE(PG8_SA(1, 1), a1 + hstepA, voffA);
            PG8_WAIT_L(8); PG8_BAR; PG8_WAIT_L(0); PG8_MMA(0, 0, At, B0); PG8_BAR; PG8_SCHED;
            PG8_LDB(B1, 0, 1); PG8_STAGE(PG8_SB(0, 0), b2, voffB);
            PG8_BAR; PG8_WAIT_L(0); PG8_MMA(0, 1, At, B1); PG8_BAR;
            PG8_LDA(At, 0, 1); PG8_STAGE(PG8_SA(0, 0), a2, voffA);
            PG8_BAR; PG8_WAIT_L(0); PG8_MMA(1, 0, At, B0); PG8_BAR; PG8_SCHED;
            PG8_STAGE(PG8_SB(0, 1), b2 + hstepB, voffB);
            PG8_WAIT_V(6); PG8_BAR; PG8_MMA(1, 1, At, B1); PG8_BAR;
            PG8_LDB(B0, 1, 0); PG8_SCHED; PG8_LDA(At, 1, 0); PG8_STAGE(PG8_SA(0, 1), a2 + hstepA, voffA);
            PG8_WAIT_L(8); PG8_BAR; PG8_WAIT_L(0); PG8_MMA(0, 0, At, B0); PG8_BAR; PG8_SCHED;
            PG8_LDB(B1, 1, 1); PG8_STAGE(PG8_SB(1, 0), b3, voffB);
            PG8_BAR; PG8_WAIT_L(0); PG8_MMA(0, 1, At, B1); PG8_BAR;
            PG8_LDA(At, 1, 1); PG8_STAGE(PG8_SA(1, 0), a3, voffA);
            PG8_BAR; PG8_WAIT_L(0); PG8_MMA(1, 0, At, B0); PG8_BAR; PG8_SCHED;
            PG8_STAGE(PG8_SB(1, 1), b3 + hstepB, voffB);
            PG8_WAIT_V(6); PG8_BAR; PG8_MMA(1, 1, At, B1); PG8_BAR;
            }
        }
        if constexpr (ALIGN_EPI) { if (wr == 0) PG8_BAR; }
        if constexpr (!Epi::AFTER_DRAIN) { E(acc, cur, wr, wc, fr, fq); S.done(cur); }
        if (!has_next) break;
#pragma unroll
        for (int a = 0; a < 2; ++a)
#pragma unroll
            for (int b = 0; b < 2; ++b)
#pragma unroll
                for (int m = 0; m < 4; ++m)
#pragma unroll
                    for (int n = 0; n < 2; ++n) acc[a][b][m][n] = (f32x4){0.f, 0.f, 0.f, 0.f};
        cur = nxt; cA = nA; cB = nB; ++ui;
        if constexpr (ALIGN_EPI) { if (wr == 1) PG8_BAR; }
    }
    PG8_WAIT_V(0);
    if constexpr (!ALIGN_EPI) { if (wr == 0) PG8_BAR; }
    PG8_BAR;
    if constexpr (Epi::AFTER_DRAIN) { E.fused(acc, cur, wr, wc, fr, fq, lds, wid, lane); S.done(cur); }
#undef PG8_SA
#undef PG8_SB
#undef PG8_STAGE
#undef PG8_LDA
#undef PG8_LDB
#undef PG8_MMA
#undef PG8_WAIT_V
#undef PG8_WAIT_L
#undef PG8_BAR
#undef PG8_SCHED
}
}
#define LAS __attribute__((address_space(3)))
typedef unsigned short bf16;
typedef short bf16x8 __attribute__((ext_vector_type(8)));
typedef float f32x4 __attribute__((ext_vector_type(4)));
typedef unsigned u32x4 __attribute__((ext_vector_type(4)));
typedef unsigned u32x2 __attribute__((ext_vector_type(2)));
constexpr int BATCH = 8, SEQ = 4096, DM = 1024, M = BATCH * SEQ, DEPTH = 4;
constexpr int REC_IN = 4624, PROJ_LD = 4864, REC_OUT = 2048, QKV_LD = 3072, FFN_H = 2816, GU_N = 5632;
constexpr int C_LRUX = 0, C_GATE = 1024, C_Z = 2048, C_XS = 3072, C_B = 4096, C_C = 4352;
constexpr float EPS = 1e-6f;
constexpr int NWAVES = 8, NTHREADS = 512;
constexpr int LDS_BYTES = 147456;
constexpr size_t MiB = 1u << 20;
constexpr size_t W_REC_IN = 0, W_REC_OUT = 19922944, W_QKV = 28311552, W_ATT_OUT = 40894464, W_GU = 45088768, W_DOWN = 91226112, W_LRU = 114294784, W_DTW = 114819072, W_END = 114819072 + 65536;
constexpr size_t SZ_REC_IN = 9961472, SZ_REC_OUT = 4194304, SZ_QKV = 6291456, SZ_ATT_OUT = 2097152, SZ_GU = 11534336, SZ_DOWN = 5767168, SZ_LRU = 131072;
constexpr size_t WS_H = 110 * MiB, WS_PROJ = 174 * MiB, WS_DT = 478 * MiB, WS_HALO = 481 * MiB, WS_RS = 489 * MiB, WS_CTL = 491 * MiB, WS_SSQ = 492 * MiB, WS_END = 500 * MiB;
static_assert(W_END <= WS_H && WS_H + (size_t)M * DM * 2 <= WS_PROJ && WS_PROJ + (size_t)M * PROJ_LD * 2 <= WS_DT && WS_HALO + (size_t)BATCH * 64 * 3 * 2560 * 2 <= WS_END, "ws map");

__device__ __forceinline__ unsigned f2bf(float f) { unsigned u = __builtin_bit_cast(unsigned, f); return (u + 0x7fffu + ((u >> 16) & 1u)) >> 16; }
__device__ __forceinline__ float bf2f(unsigned h) { return __builtin_bit_cast(float, h << 16); }
__device__ __forceinline__ unsigned pk2(float lo, float hi) { typedef float f32x2_t __attribute__((ext_vector_type(2))); typedef __bf16 bf16x2_t __attribute__((ext_vector_type(2))); const f32x2_t v = {lo, hi}; const bf16x2_t bb = __builtin_convertvector(v, bf16x2_t); return __builtin_bit_cast(unsigned, bb); }
__device__ __forceinline__ float bflo(unsigned w) { return __builtin_bit_cast(float, w << 16); }
__device__ __forceinline__ float bfhi(unsigned w) { return __builtin_bit_cast(float, w & 0xffff0000u); }
__device__ __forceinline__ void unpack8(const u32x4 v, float* x) { x[0] = bflo(v.x); x[1] = bfhi(v.x); x[2] = bflo(v.y); x[3] = bfhi(v.y); x[4] = bflo(v.z); x[5] = bfhi(v.z); x[6] = bflo(v.w); x[7] = bfhi(v.w); }
__device__ __forceinline__ u32x4 pack8(const float* x) { u32x4 v; v.x = pk2(x[0], x[1]); v.y = pk2(x[2], x[3]); v.z = pk2(x[4], x[5]); v.w = pk2(x[6], x[7]); return v; }
#define LDS_FENCE() asm volatile("s_waitcnt lgkmcnt(0)" ::: "memory")
__device__ __forceinline__ float wave_sum(float v) {
#pragma unroll
    for (int o = 1; o < 64; o <<= 1) v += __shfl_xor(v, o);
    return v;
}
__device__ __forceinline__ float softplus_f(float x) { return x > 20.f ? x : log1pf(__expf(x)); }
__device__ __forceinline__ float gelu_tanh(float x) { const float y = 0.7978845608028654f * (x + 0.044715f * x * x * x); const float e = pg8::fast_exp(2.f * y); const float t = 1.f - 2.f * __builtin_amdgcn_rcpf(e + 1.f); return 0.5f * x * (1.f + t); }

struct Ctx {
    LAS unsigned char* lds; int tid, lane, wave, G, bid;
    float* out; unsigned char* ws;
};

__device__ __forceinline__ void transpose_item(const float* W, int K, int ldw, int ncv, int src_col0, bf16* WT, int dst_row0, LAS float* scr, int k0, int lane, const float* gain, const bool swap48 = false) {
    { const int c4 = (lane & 7) * 4, c4s = (swap48 && (c4 == 4 || c4 == 8)) ? 12 - c4 : c4, col = src_col0 + c4s; const bool ok = col < ncv;
      f32x4 v[8];
#pragma unroll
      for (int i = 0; i < 8; ++i) { const int kk = 8 * i + (lane >> 3); v[i] = ok ? *(const f32x4*)(W + (size_t)(k0 + kk) * ldw + col) : (f32x4){0.f, 0.f, 0.f, 0.f}; }
#pragma unroll
      for (int i = 0; i < 8; ++i) { const int kk = 8 * i + (lane >> 3); const float gk = gain ? gain[k0 + kk] : 1.0f;
          scr[kk * 33 + c4] = v[i][0] * gk; scr[kk * 33 + c4 + 1] = v[i][1] * gk; scr[kk * 33 + c4 + 2] = v[i][2] * gk; scr[kk * 33 + c4 + 3] = v[i][3] * gk; } }
    LDS_FENCE();
    const int c = lane & 7;
#pragma unroll
    for (int jj = 0; jj < 4; ++jj) { const int n = (lane >> 3) + 8 * jj; const LAS float* s = scr + (8 * c) * 33 + n;
        u32x4 o; o.x = pk2(s[0 * 33], s[1 * 33]); o.y = pk2(s[2 * 33], s[3 * 33]); o.z = pk2(s[4 * 33], s[5 * 33]); o.w = pk2(s[6 * 33], s[7 * 33]);
        *(u32x4*)(WT + (size_t)(dst_row0 + n) * K + k0 + 8 * c) = o; }
    LDS_FENCE();
}
__device__ __forceinline__ void p0_weights(Ctx& F, const float* w_rec_in, const float* w_rec_out, const float* w_qkv, const float* w_att_out, const float* w_gu, const float* w_down, const float* w_lr, const float* w_li, const float* g_rec, const float* g_att, const float* g_ffn, const float* x_in) {
    LAS float* scr = (LAS float*)(F.lds + F.wave * 8448);
    const int gw = F.bid * NWAVES + F.wave, NGW = F.G * NWAVES; const int gt0_ = F.bid * NTHREADS + F.tid, NT0_ = F.G * NTHREADS;
    constexpr int TOTAL = 4608 + 2048 + 3072 + 1024 + 11264 + 5632;
    for (int it = gw; it < TOTAL; it += NGW) {
        int r = it; const float* W; const float* gain = nullptr; int K, ldw, ncv, nbn, kind = 0; bf16* WT;
        if (r < 4608) { const int i = r / 2304; r %= 2304; W = w_rec_in + (size_t)i * 1024 * REC_IN; gain = g_rec + i * DM; K = 1024; ldw = REC_IN; ncv = REC_IN; nbn = 144; WT = (bf16*)(F.ws + W_REC_IN + i * SZ_REC_IN); }
        else { r -= 4608;
        if (r < 2048) { const int i = r / 1024; r %= 1024; W = w_rec_out + (size_t)i * 2048 * 1024; K = 2048; ldw = 1024; ncv = 1024; nbn = 32; WT = (bf16*)(F.ws + W_REC_OUT + i * SZ_REC_OUT); }
        else { r -= 2048;
        if (r < 3072) { const int i = r / 1536; r %= 1536; W = w_qkv + (size_t)i * 1024 * 3072; gain = g_att + i * DM; K = 1024; ldw = 3072; ncv = 3072; nbn = 96; kind = 2; WT = (bf16*)(F.ws + W_QKV + i * SZ_QKV); }
        else { r -= 3072;
        if (r < 1024) { const int i = r / 512; r %= 512; W = w_att_out + (size_t)i * 1024 * 1024; K = 1024; ldw = 1024; ncv = 1024; nbn = 32; WT = (bf16*)(F.ws + W_ATT_OUT + i * SZ_ATT_OUT); }
        else { r -= 1024;
        if (r < 11264) { const int l = r / 2816; r %= 2816; W = w_gu + (size_t)l * 1024 * GU_N; gain = g_ffn + l * DM; K = 1024; ldw = GU_N; ncv = GU_N; nbn = 176; kind = 1; WT = (bf16*)(F.ws + W_GU + l * SZ_GU); }
        else { r -= 11264; const int l = r / 1408; r %= 1408; W = w_down + (size_t)l * FFN_H * 1024; K = FFN_H; ldw = 1024; ncv = 1024; nbn = 32; WT = (bf16*)(F.ws + W_DOWN + l * SZ_DOWN); } } } } }
        const int kb = r / nbn, nb = r % nbn, n0 = 32 * nb; int src = n0;
        if (kind == 1) { const int tile = n0 >> 8, within = n0 & 255; src = within < 128 ? 128 * tile + within : FFN_H + 128 * tile + (within - 128); }
        bool swap48 = false;
        if (kind == 2 && n0 < 2048) { const int t = n0 >> 8, within = n0 & 255, bj = within >> 7, wc = (within >> 5) & 3; src = (t >> 2) * 1024 + (4 * (t & 3) + wc) * 64 + bj * 32; swap48 = (bj == 0); }
        transpose_item(W, K, ldw, ncv, src, WT, n0, scr, 64 * kb, F.lane, gain, swap48);
    }
    for (int m = gw; m < M; m += NGW) {
        const f32x4* xr = (const f32x4*)(x_in + (size_t)m * DM) + F.lane; f32x4 v[4]; float s = 0.f;
#pragma unroll
        for (int jj = 0; jj < 4; ++jj) { v[jj] = xr[64 * jj]; s += (v[jj].x * v[jj].x + v[jj].y * v[jj].y) + (v[jj].z * v[jj].z + v[jj].w * v[jj].w); }
        s = wave_sum(s);
        u32x2* o8 = (u32x2*)((bf16*)(F.ws + WS_H) + (size_t)m * DM) + F.lane;
#pragma unroll
        for (int jj = 0; jj < 4; ++jj) { u32x2 w; w.x = pk2(v[jj].x, v[jj].y); w.y = pk2(v[jj].z, v[jj].w); o8[64 * jj] = w; }
        if (F.lane < 16) ((float*)(F.ws + WS_RS))[(size_t)m * 16 + F.lane] = (F.lane == 0) ? s : 0.f;
    }
    for (int i = gt0_; i < BATCH * 3 * 320; i += NT0_) { const int bq = i / 960, rem = i % 960; *(u32x4*)((bf16*)(F.ws + WS_HALO) + (size_t)(bq * 192 + rem / 320) * 2560 + (rem % 320) * 8) = (u32x4){0u, 0u, 0u, 0u}; }
    for (int idx = gt0_; idx < 2 * 16 * 1024; idx += NT0_) { const int ly = idx >> 14, jc = (idx >> 10) & 15, k = idx & 1023;
        ((bf16*)(F.ws + W_DTW))[idx] = (bf16)f2bf(g_rec[ly * DM + k] * w_rec_in[(size_t)ly * 1024 * REC_IN + (size_t)k * REC_IN + 4608 + jc]); }
    const int gt = F.bid * NTHREADS + F.tid, NT = F.G * NTHREADS;
    for (int idx = gt; idx < 4 * 65536; idx += NT) { const int mat = idx >> 16, e = idx & 65535, h = e >> 12, jj = (e >> 6) & 63, ii = e & 63;
        const float* src = (mat & 1) ? w_li : w_lr; const int layer = mat >> 1;
        ((bf16*)(F.ws + W_LRU))[(size_t)mat * 65536 + e] = (bf16)f2bf(src[(size_t)layer * 65536 + h * 4096 + ii * 64 + jj]); }
}
__device__ __forceinline__ void norm_phase(Ctx& F, const float* x, const float* gain, bf16* out) {
    const int gw = F.bid * NWAVES + F.wave, NGW = F.G * NWAVES;
    f32x4 gv[4];
#pragma unroll
    for (int jj = 0; jj < 4; ++jj) gv[jj] = ((const f32x4*)gain)[F.lane + 64 * jj];
    for (int m = gw; m < M; m += NGW) {
        const f32x4* xr = (const f32x4*)(x + (size_t)m * DM) + F.lane; f32x4 v[4]; float s = 0.f;
#pragma unroll
        for (int jj = 0; jj < 4; ++jj) { v[jj] = xr[64 * jj]; s += (v[jj].x * v[jj].x + v[jj].y * v[jj].y) + (v[jj].z * v[jj].z + v[jj].w * v[jj].w); }
        const float rs = 1.0f / sqrtf(wave_sum(s) * (1.f / DM) + EPS);
        u32x2* o8 = (u32x2*)(out + (size_t)m * DM) + F.lane;
#pragma unroll
        for (int jj = 0; jj < 4; ++jj) { u32x2 w; w.x = pk2(v[jj].x * rs * gv[jj].x, v[jj].y * rs * gv[jj].y); w.y = pk2(v[jj].z * rs * gv[jj].z, v[jj].w * rs * gv[jj].w); o8[64 * jj] = w; }
    }
}
__device__ __forceinline__ void halo_phase(Ctx& F) {
    const bf16* proj = (const bf16*)(F.ws + WS_PROJ); bf16* halo = (bf16*)(F.ws + WS_HALO);
    const int gw = F.bid * NWAVES + F.wave, NGW = F.G * NWAVES;
    for (int hr = gw; hr < BATCH * 64 * 3; hr += NGW) {
        const int b = hr / 192, rem = hr % 192, c = rem / 3, jj = rem % 3, t = c * 64 - 3 + jj;
#pragma unroll
        for (int q = 0; q < 5; ++q) { const int gidx = F.lane + 64 * q; const int col = gidx < 128 ? gidx * 8 : C_XS + (gidx - 128) * 8;
            u32x4 v; if (t >= 0) v = *(const u32x4*)(proj + (size_t)(b * SEQ + t) * PROJ_LD + col); else { unsigned z_; asm volatile("v_mov_b32 %0, 0" : "=v"(z_)); v = (u32x4){z_, z_, z_, z_}; }
            *(u32x4*)(halo + (size_t)hr * 2560 + gidx * 8) = v; }
    }
}
__device__ __forceinline__ void conv_phase(Ctx& F, int li, const float* lcw, const float* lcb, const float* scw, const float* scb) {
    bf16* proj = (bf16*)(F.ws + WS_PROJ); const bf16* halo = (const bf16*)(F.ws + WS_HALO);
    if (F.tid >= 320) {
        const int lane = F.lane, j = lane & 15, g = lane >> 4, wv = F.wave - 5;
        const bf16* xb = (const bf16*)(F.ws + WS_H); const bf16* wdt = (const bf16*)(F.ws + W_DTW) + (size_t)li * 16 * 1024 + (size_t)j * 1024 + 8 * g;
        float* dtb_ = (float*)(F.ws + WS_DT); const float* rs = (const float*)(F.ws + WS_RS);
        for (int it = F.bid; it < BATCH * 64; it += F.G) {
            const int t_lo = wv == 0 ? 0 : wv + 1, t_hi = wv == 0 ? 2 : wv + 2;
            for (int tl = t_lo; tl < t_hi; ++tl) { const int R0 = it * 64 + 16 * tl;
                const bf16* ap = xb + (size_t)(R0 + j) * DM + 8 * g; f32x4 acc = (f32x4){0.f, 0.f, 0.f, 0.f};
#pragma unroll 8
                for (int ks = 0; ks < 32; ++ks) acc = __builtin_amdgcn_mfma_f32_16x16x32_bf16(*(const bf16x8*)(ap + 32 * ks), *(const bf16x8*)(wdt + 32 * ks), acc, 0, 0, 0);
#pragma unroll
                for (int r = 0; r < 4; ++r) { const int row = R0 + 4 * g + r; dtb_[(size_t)row * 16 + j] = acc[r] * pg8::row_rs(rs, row); } } }
        return; }
    const int gidx = F.tid; const bool ssd = gidx >= 128; const int col = ssd ? C_XS + (gidx - 128) * 8 : gidx * 8;
    const float* cw = ssd ? scw + (size_t)li * 4 * 1536 + (gidx - 128) * 8 : lcw + (size_t)li * 4 * 1024 + gidx * 8;
    const float* cb = ssd ? scb + (size_t)li * 1536 + (gidx - 128) * 8 : lcb + (size_t)li * 1024 + gidx * 8;
    const int cstride = ssd ? 1536 : 1024;
    float w[4][8], bias[8];
#pragma unroll
    for (int jj = 0; jj < 4; ++jj)
#pragma unroll
        for (int e = 0; e < 8; ++e) w[jj][e] = cw[jj * cstride + e];
#pragma unroll
    for (int e = 0; e < 8; ++e) bias[e] = cb[e];
    for (int it = F.bid; it < BATCH * 64; it += F.G) {
        const int b = it >> 6, c = it & 63;
        float p3[8], p2[8], p1[8];
        { const bf16* hp = halo + (size_t)(it * 3) * 2560 + gidx * 8;
          unpack8(*(const u32x4*)hp, p3); unpack8(*(const u32x4*)(hp + 2560), p2); unpack8(*(const u32x4*)(hp + 5120), p1); }
        bf16* pp = proj + (size_t)(b * SEQ + c * 64) * PROJ_LD + col;
#pragma unroll 16
        for (int t = 0; t < 64; ++t) {
            float cur[8], y[8]; unpack8(*(const u32x4*)(pp + (size_t)t * PROJ_LD), cur);
#pragma unroll
            for (int e = 0; e < 8; ++e) { float v = bias[e] + w[0][e] * p3[e] + w[1][e] * p2[e] + w[2][e] * p1[e] + w[3][e] * cur[e]; if (ssd) v = pg8::fast_silu(v); y[e] = v; p3[e] = p2[e]; p2[e] = p1[e]; p1[e] = cur[e]; }
            *(u32x4*)(pp + (size_t)t * PROJ_LD) = pack8(y);
        }
    }
}
#define MFMA16(a, b, c) __builtin_amdgcn_mfma_f32_16x16x32_bf16((a), (b), (c), 0, 0, 0)
__device__ __forceinline__ void lru_item(Ctx& F, int li, int b, int blk, const float* p_br, const float* p_bi, const float* p_lam, const bool wr = true) {
    LAS float* sa = (LAS float*)F.lds;
    LAS float* su = sa + 128 * 68;
    LAS float* segA = su + 128 * 68;
    LAS float* segH = segA + 512;
    const int lane = F.lane, wave = F.wave, j = lane & 15, g = lane >> 4;
    LAS bf16* xs = (LAS bf16*)(segH + 512) + wave * (16 * 72);
    LAS bf16* gs = (LAS bf16*)(segH + 512) + 8 * (16 * 72) + wave * (16 * 72);
    const bf16* WrT = (const bf16*)(F.ws + W_LRU) + (size_t)(2 * li) * 65536 + blk * 4096;
    const bf16* WiT = (const bf16*)(F.ws + W_LRU) + (size_t)(2 * li + 1) * 65536 + blk * 4096;
    bf16x8 br[4][2], bi[4][2]; float biasr[4], biasi[4], c8sp[4];
#pragma unroll
    for (int nt = 0; nt < 4; ++nt) {
#pragma unroll
        for (int ks = 0; ks < 2; ++ks) { br[nt][ks] = *(const bf16x8*)(WrT + (16 * nt + j) * 64 + 32 * ks + 8 * g); bi[nt][ks] = *(const bf16x8*)(WiT + (16 * nt + j) * 64 + 32 * ks + 8 * g); }
        const int c = li * 1024 + blk * 64 + 16 * nt + j; biasr[nt] = p_br[c]; biasi[nt] = p_bi[c]; c8sp[nt] = 8.0f * log1pf(__expf(-p_lam[c])); }
    float hprev = 0.f;
    bf16* xbase = (bf16*)(F.ws + WS_PROJ) + (size_t)b * SEQ * PROJ_LD + blk * 64;
    const bf16* ap = xbase + (size_t)(16 * wave + j) * PROJ_LD + 8 * g;
    bf16* gpt = xbase + C_GATE + (size_t)(16 * wave + (lane >> 2)) * PROJ_LD + 16 * (lane & 3);
    bf16x8 na0 = *(const bf16x8*)ap, na1 = *(const bf16x8*)(ap + 32);
    u32x4 ng0 = *(const u32x4*)gpt, ng1 = *(const u32x4*)(gpt + 8);
    for (int ch = 0; ch < 32; ++ch) {
        const bf16x8 a0 = na0, a1 = na1; const u32x4 g0 = ng0, g1 = ng1;
        if (ch + 1 < 32) { const size_t o = (size_t)(ch + 1) * 128 * PROJ_LD; na0 = *(const bf16x8*)(ap + o); na1 = *(const bf16x8*)(ap + o + 32); ng0 = *(const u32x4*)(gpt + o); ng1 = *(const u32x4*)(gpt + o + 8); }
        *(LAS bf16x8*)(xs + j * 72 + 8 * g) = a0; *(LAS bf16x8*)(xs + j * 72 + 32 + 8 * g) = a1;
        *(LAS u32x4*)(gs + (lane >> 2) * 72 + 16 * (lane & 3)) = g0; *(LAS u32x4*)(gs + (lane >> 2) * 72 + 16 * (lane & 3) + 8) = g1;
        LDS_FENCE();
#pragma unroll
        for (int nt = 0; nt < 4; ++nt) {
            f32x4 dr = (f32x4){0.f, 0.f, 0.f, 0.f}, di = (f32x4){0.f, 0.f, 0.f, 0.f};
            dr = MFMA16(a0, br[nt][0], dr); dr = MFMA16(a1, br[nt][1], dr);
            di = MFMA16(a0, bi[nt][0], di); di = MFMA16(a1, bi[nt][1], di);
#pragma unroll
            for (int r = 0; r < 4; ++r) { const int tl = 16 * wave + 4 * g + r, c = 16 * nt + j;
                const float xc = bf2f(xs[(4 * g + r) * 72 + c]);
                const float rg = pg8::fast_sigmoid(dr[r] + biasr[nt]), ig = pg8::fast_sigmoid(di[r] + biasi[nt]);
                const float la = -rg * c8sp[nt]; const float a = pg8::fast_exp(la); const float u = __builtin_amdgcn_sqrtf(fmaxf(1.0f - a * a, 0.f)) * ig * xc;
                sa[tl * 68 + c] = a; su[tl * 68 + c] = u; } }
        __syncthreads();
        { float A = 1.f, H = 0.f;
#pragma unroll
          for (int k = 0; k < 16; ++k) { const int idx = (16 * wave + k) * 68 + lane; const float a = sa[idx], u = su[idx]; H = a * H + u; A = A * a; su[idx] = H; sa[idx] = A; }
          segA[wave * 64 + lane] = A; segH[wave * 64 + lane] = H; }
        __syncthreads();
        float carry = hprev, hp = hprev;
#pragma unroll
        for (int w2 = 0; w2 < 8; ++w2) { const float A = segA[w2 * 64 + lane], H = segH[w2 * 64 + lane]; if (w2 == wave) carry = hp; hp = A * hp + H; }
        hprev = hp;
#pragma unroll 4
        for (int k = 0; k < 16; ++k) { const int idx = (16 * wave + k) * 68 + lane; const float h = su[idx] + sa[idx] * carry;
            const float gate = bf2f(gs[k * 72 + lane]); gs[k * 72 + lane] = (bf16)f2bf(h * gate); }
        LDS_FENCE();
        if (wr) { bf16* op = gpt + (size_t)ch * 128 * PROJ_LD; *(u32x4*)op = *(const LAS u32x4*)(gs + (lane >> 2) * 72 + 16 * (lane & 3)); *(u32x4*)(op + 8) = *(const LAS u32x4*)(gs + (lane >> 2) * 72 + 16 * (lane & 3) + 8); }
        __syncthreads();
    }
}
template <int K>
__device__ __forceinline__ f32x4 mma_lds(f32x4 acc, const LAS bf16* A, int pitchA, int rowA0, const LAS bf16* Bt, int pitchB, int rowB0, int j, int g) {
#pragma unroll
    for (int ks = 0; ks < K / 32; ++ks) { const bf16x8 a = *(const LAS bf16x8*)(A + (rowA0 + j) * pitchA + 32 * ks + 8 * g); const bf16x8 bb = *(const LAS bf16x8*)(Bt + (rowB0 + j) * pitchB + 32 * ks + 8 * g); acc = MFMA16(a, bb, acc); }
    return acc;
}
__device__ __forceinline__ void ssd_item(Ctx& F, int li, int b, int head, const float* p_dtb, const float* p_alog, const float* p_d, const bool wr = true) {
    LAS bf16* Cs = (LAS bf16*)F.lds;
    LAS bf16* Bs = Cs + 64 * 136;
    LAS bf16* BT = Bs + 64 * 136;
    LAS bf16* XT = BT + 128 * 72;
    LAS bf16* XwT = XT + 64 * 72;
    LAS bf16* Ms = XwT + 64 * 72;
    LAS bf16* Ss = Ms + 64 * 72;
    LAS float* csv = (LAS float*)(Ss + 64 * 136);
    LAS float* dtv = csv + 64;
    LAS float* wv = dtv + 64;
    LAS bf16* Zs = (LAS bf16*)(wv + 64);
    const int tid = F.tid, lane = F.lane, wave = F.wave, j = lane & 15, g = lane >> 4, grp = head >> 3;
    const float a_h = -__expf(p_alog[li * 16 + head]), dtb = p_dtb[li * 16 + head], Dh = p_d[li * 16 + head];
    bf16* proj = (bf16*)(F.ws + WS_PROJ) + (size_t)b * SEQ * PROJ_LD;
    const bf16* pB = proj + C_B + 128 * grp; const bf16* pC = proj + C_C + 128 * grp; const bf16* pX = proj + C_XS + 64 * head; bf16* pZ = proj + C_Z + 64 * head;
    const float* dtp = (const float*)(F.ws + WS_DT) + (size_t)b * SEQ * 16 + head;
    float* ssq = (float*)(F.ws + WS_SSQ) + (size_t)b * SEQ * 32 + grp * 16 + (head & 7) * 2 + (wave & 1);
    f32x4 sacc[4];
#pragma unroll
    for (int pt = 0; pt < 4; ++pt) sacc[pt] = (f32x4){0.f, 0.f, 0.f, 0.f};
    for (int i = tid; i < 64 * 136 / 2; i += NTHREADS) ((LAS unsigned*)Ss)[i] = 0u;
    const int row = tid >> 3, cseg = (tid & 7) * 8;
    u32x4 rB0, rB1, rC0, rC1, rX, rZ; float rdt = 0.f;
    { const size_t o = (size_t)row * PROJ_LD + cseg; rB0 = *(const u32x4*)(pB + o); rB1 = *(const u32x4*)(pB + o + 64); rC0 = *(const u32x4*)(pC + o); rC1 = *(const u32x4*)(pC + o + 64); rX = *(const u32x4*)(pX + o); rZ = *(const u32x4*)(pZ + o);
      if (wave == 0) rdt = dtp[(size_t)lane * 16]; }
    for (int c = 0; c < 64; ++c) {
        const int tok0 = c * 64;
        if (c > 0 && wr) *(u32x4*)(pZ + (size_t)(tok0 - 64 + row) * PROJ_LD + cseg) = *(const LAS u32x4*)(Zs + row * 72 + cseg);
        *(LAS u32x4*)(Zs + row * 72 + cseg) = rZ;
        *(LAS u32x4*)(Cs + row * 136 + cseg) = rC0; *(LAS u32x4*)(Cs + row * 136 + cseg + 64) = rC1;
        *(LAS u32x4*)(Bs + row * 136 + cseg) = rB0; *(LAS u32x4*)(Bs + row * 136 + cseg + 64) = rB1;
        { const unsigned wds[8] = {rB0.x, rB0.y, rB0.z, rB0.w, rB1.x, rB1.y, rB1.z, rB1.w};
#pragma unroll
          for (int q = 0; q < 8; ++q) { const int n = cseg + (q >> 2) * 64 + (q & 3) * 2; BT[n * 72 + row] = (bf16)(wds[q] & 0xffffu); BT[(n + 1) * 72 + row] = (bf16)(wds[q] >> 16); } }
        if (wave == 0) {
            const float dt = softplus_f(rdt + dtb); float cs = dt * a_h;
#pragma unroll
            for (int off = 1; off < 64; off <<= 1) { const float v = __shfl_up(cs, off); if (lane >= off) cs += v; }
            const float tot = __shfl(cs, 63);
            csv[lane] = cs; dtv[lane] = dt; wv[lane] = dt * __expf(tot - cs);
        }
        __syncthreads();
        { float x[8]; unpack8(rX, x); const float wr_ = wv[row];
#pragma unroll
          for (int e = 0; e < 8; ++e) { XT[(cseg + e) * 72 + row] = (bf16)f2bf(x[e]); XwT[(cseg + e) * 72 + row] = (bf16)f2bf(x[e] * wr_); } }
        __syncthreads();
        if (c + 1 < 64) { const size_t o = (size_t)(tok0 + 64 + row) * PROJ_LD + cseg; rB0 = *(const u32x4*)(pB + o); rB1 = *(const u32x4*)(pB + o + 64); rC0 = *(const u32x4*)(pC + o); rC1 = *(const u32x4*)(pC + o + 64); rX = *(const u32x4*)(pX + o); rZ = *(const u32x4*)(pZ + o);
            if (wave == 0) rdt = dtp[(size_t)(tok0 + 64 + lane) * 16]; }
        const int lt = wave >> 1; f32x4 yacc[2];
#pragma unroll
        for (int q = 0; q < 2; ++q) { const int st = 2 * (wave & 1) + q;
            f32x4 G = mma_lds<128>((f32x4){0.f, 0.f, 0.f, 0.f}, Cs, 136, 16 * lt, Bs, 136, 16 * st, j, g);
            const int s = 16 * st + j; const float css = csv[s], dts = dtv[s];
#pragma unroll
            for (int r = 0; r < 4; ++r) { const int l = 16 * lt + 4 * g + r; const float dd = csv[l] - css; const float val = (s <= l) ? G[r] * __expf(fminf(dd, 0.f)) * dts : 0.f; Ms[l * 72 + s] = (bf16)f2bf(val); }
            f32x4 yo = mma_lds<128>((f32x4){0.f, 0.f, 0.f, 0.f}, Cs, 136, 16 * lt, Ss, 136, 16 * st, j, g);
#pragma unroll
            for (int r = 0; r < 4; ++r) yo[r] *= __expf(csv[16 * lt + 4 * g + r]);
            yacc[q] = yo; }
        __syncthreads();
        float sq[4] = {0.f, 0.f, 0.f, 0.f};
#pragma unroll
        for (int q = 0; q < 2; ++q) { const int pt = 2 * (wave & 1) + q; yacc[q] = mma_lds<64>(yacc[q], Ms, 72, 16 * lt, XT, 72, 16 * pt, j, g);
            const int p = 16 * pt + j;
#pragma unroll
            for (int r = 0; r < 4; ++r) { const int l = 16 * lt + 4 * g + r; const float x = bf2f(XT[p * 72 + l]); const float y = yacc[q][r] + Dh * x;
                const float z = bf2f(Zs[l * 72 + p]); const float v = y * pg8::fast_silu(z); Zs[l * 72 + p] = (bf16)f2bf(v); sq[r] += v * v; } }
#pragma unroll
        for (int r = 0; r < 4; ++r) { float s = sq[r]; s += __shfl_xor(s, 1); s += __shfl_xor(s, 2); s += __shfl_xor(s, 4); s += __shfl_xor(s, 8);
            if (j == 0 && wr) ssq[(size_t)(tok0 + 16 * lt + 4 * g + r) * 32] = s; }
        const float dec = __expf(csv[63]);
#pragma unroll
        for (int pt = 0; pt < 4; ++pt) { sacc[pt] = sacc[pt] * dec; sacc[pt] = mma_lds<64>(sacc[pt], XwT, 72, 16 * pt, BT, 72, 16 * wave, j, g);
#pragma unroll
            for (int r = 0; r < 4; ++r) Ss[(16 * pt + 4 * g + r) * 136 + 16 * wave + j] = (bf16)f2bf(sacc[pt][r]); }
        __syncthreads();
    }
    if (wr) *(u32x4*)(pZ + (size_t)(63 * 64 + row) * PROJ_LD + cseg) = *(const LAS u32x4*)(Zs + row * 72 + cseg);
}
typedef short v4i16_t __attribute__((ext_vector_type(4)));
__device__ __forceinline__ bf16x8 tr_frag(const LAS bf16* T, int pitch, int row0, int col0, int lane) {
    const LAS bf16* a = T + (row0 + 8 * (lane >> 4) + ((lane & 15) >> 2)) * pitch + col0 + 4 * (lane & 3);
    const v4i16_t t0 = __builtin_amdgcn_ds_read_tr16_b64_v4i16((LAS v4i16_t*)a);
    const v4i16_t t1 = __builtin_amdgcn_ds_read_tr16_b64_v4i16((LAS v4i16_t*)(a + 4 * pitch));
    return (bf16x8){t0[0], t0[1], t0[2], t0[3], t1[0], t1[1], t1[2], t1[3]};
}
constexpr size_t SSD_STATE_OFF = 0, SSD_DEC_OFF = 40 * MiB;
template <int PASS>
__device__ __forceinline__ void ssd_seg_item(Ctx& F, int li, int b, int hp, int seg, const float* p_dtb, const float* p_alog, const float* p_d) {
    LAS bf16* Bs = (LAS bf16*)F.lds;
    LAS bf16* Cs = Bs + 64 * 144;
    LAS bf16* Gs = Cs + 64 * 136;
    const int tid = F.tid, lane = F.lane, wave = F.wave, j = lane & 15, g = lane >> 4;
    LAS bf16* Xw_ = Gs + 2 * 64 * 72 + wave * (2 * 64 * 24);
    LAS bf16* Zw_ = Xw_ + 64 * 24;
    LAS float* csw = (LAS float*)(Gs + 2 * 64 * 72 + 8 * (2 * 64 * 24)) + (wave >> 2) * 192;
    LAS float* dtw = csw + 64; LAS float* ww = dtw + 64;
    const int head = 2 * hp + (wave >> 2), ph = wave & 3, grp = head >> 3;
    const float a_h = -__expf(p_alog[li * 16 + head]), dtb = p_dtb[li * 16 + head], Dh = p_d[li * 16 + head];
    bf16* proj = (bf16*)(F.ws + WS_PROJ) + (size_t)(b * SEQ + seg * 512) * PROJ_LD;
    const bf16* pB = proj + C_B + 128 * grp; const bf16* pC = proj + C_C + 128 * grp; const bf16* pX = proj + C_XS + 64 * head + 16 * ph; bf16* pZ = proj + C_Z + 64 * head + 16 * ph;
    const float* dtp = (const float*)(F.ws + WS_DT) + (size_t)(b * SEQ + seg * 512) * 16 + head;
    float* ssq = (float*)(F.ws + WS_SSQ) + (size_t)(b * SEQ + seg * 512) * 64 + grp * 32 + (head & 7) * 4 + ph;
    f32x4* Sst = (f32x4*)((unsigned char*)F.out + SSD_STATE_OFF); float* Sdec = (float*)((unsigned char*)F.out + SSD_DEC_OFF);
    const size_t sidx0 = ((size_t)((b * 16 + head) * 8) * 4 + ph) * 8 * 64 + lane;
    f32x4 sacc[8];
#pragma unroll
    for (int nt = 0; nt < 8; ++nt) sacc[nt] = (f32x4){0.f, 0.f, 0.f, 0.f};
    const int row = tid >> 3, cseg = (tid & 7) * 8;
    u32x4 rB0, rB1, rC0, rC1, rX[2], rZ[2]; float rdt;
    { const size_t o = (size_t)row * PROJ_LD + cseg; rB0 = *(const u32x4*)(pB + o); rB1 = *(const u32x4*)(pB + o + 64); if (PASS == 1) { rC0 = *(const u32x4*)(pC + o); rC1 = *(const u32x4*)(pC + o + 64); }
      const size_t ow = (size_t)lane * PROJ_LD;
#pragma unroll
      for (int q = 0; q < 2; ++q) { rX[q] = *(const u32x4*)(pX + ow + 8 * q); if (PASS == 1) rZ[q] = *(const u32x4*)(pZ + ow + 8 * q); }
      rdt = dtp[(size_t)lane * 16]; }
    if (PASS == 1) {
        for (int s2 = 0; s2 < seg; ++s2) { const float dc = __expf(Sdec[(b * 16 + head) * 8 + s2]);
#pragma unroll
            for (int nt = 0; nt < 8; ++nt) sacc[nt] = sacc[nt] * dc + Sst[sidx0 + (size_t)s2 * 2048 + nt * 64]; }
    }
    float logdec = 0.f;
    for (int c = 0; c < 8; ++c) {
        const int tok0 = c * 64;
        *(LAS u32x4*)(Bs + row * 144 + cseg) = rB0; *(LAS u32x4*)(Bs + row * 144 + cseg + 64) = rB1;
        if (PASS == 1) { *(LAS u32x4*)(Cs + row * 136 + cseg) = rC0; *(LAS u32x4*)(Cs + row * 136 + cseg + 64) = rC1; }
#pragma unroll
        for (int q = 0; q < 2; ++q) { *(LAS u32x4*)(Xw_ + lane * 24 + 8 * q) = rX[q]; if (PASS == 1) *(LAS u32x4*)(Zw_ + lane * 24 + 8 * q) = rZ[q]; }
        if (ph == 0) { const float dt = softplus_f(rdt + dtb); float cs = dt * a_h;
#pragma unroll
          for (int off = 1; off < 64; off <<= 1) { const float v = __shfl_up(cs, off); if (lane >= off) cs += v; }
          const float tot = __shfl(cs, 63);
          csw[lane] = cs; dtw[lane] = dt; ww[lane] = dt * __expf(tot - cs); logdec += tot; }
        __syncthreads();
        if (PASS == 1) {
            { const int lt = wave >> 1; const float Dh2[2] = {p_d[li * 16 + 2 * hp], p_d[li * 16 + 2 * hp + 1]};
              const LAS float* csb = csw - (wave >> 2) * 192;
#pragma unroll
              for (int q = 0; q < 2; ++q) { const int st = 2 * (wave & 1) + q;
                  const f32x4 G = mma_lds<128>((f32x4){0.f, 0.f, 0.f, 0.f}, Cs, 136, 16 * lt, Bs, 144, 16 * st, j, g);
                  const int s = 16 * st + j;
#pragma unroll
                  for (int h2 = 0; h2 < 2; ++h2) { const LAS float* c2 = csb + h2 * 192; const float css = c2[s], dts = c2[64 + s];
#pragma unroll
                      for (int r = 0; r < 4; ++r) { const int l = 16 * lt + 4 * g + r; float v = (s <= l) ? G[r] * __expf(fminf(c2[l] - css, 0.f)) * dts : 0.f; if (s == l) v += Dh2[h2]; Gs[h2 * (64 * 72) + l * 72 + s] = (bf16)f2bf(v); } } } }
            __syncthreads();
            f32x4 yacc[4];
#pragma unroll
            for (int lt = 0; lt < 4; ++lt) yacc[lt] = (f32x4){0.f, 0.f, 0.f, 0.f};
#pragma unroll
            for (int ks = 0; ks < 4; ++ks) {
                bf16x8 sf;
                { u32x4 w; w.x = pk2(sacc[2 * ks][0], sacc[2 * ks][1]); w.y = pk2(sacc[2 * ks][2], sacc[2 * ks][3]);
                    w.z = pk2(sacc[2 * ks + 1][0], sacc[2 * ks + 1][1]); w.w = pk2(sacc[2 * ks + 1][2], sacc[2 * ks + 1][3]); sf = __builtin_bit_cast(bf16x8, w); }
#pragma unroll
                for (int lt = 0; lt < 4; ++lt) { const LAS bf16* cp = Cs + (16 * lt + j) * 136 + 32 * ks + 4 * g;
                    const u32x2 c0 = *(const LAS u32x2*)cp, c1 = *(const LAS u32x2*)(cp + 16); const u32x4 cw = (u32x4){c0.x, c0.y, c1.x, c1.y}; const bf16x8 cf = __builtin_bit_cast(bf16x8, cw);
                    yacc[lt] = MFMA16(cf, sf, yacc[lt]); } }
#pragma unroll
            for (int lt = 0; lt < 4; ++lt)
#pragma unroll
                for (int r = 0; r < 4; ++r) { const float e = __expf(csw[16 * lt + 4 * g + r]); yacc[lt][r] *= e; }
            bf16x8 xf[2];
#pragma unroll
            for (int ks = 0; ks < 2; ++ks) xf[ks] = tr_frag(Xw_, 24, 32 * ks, 0, lane);
            { const LAS bf16* Mh = Gs + (wave >> 2) * (64 * 72);
#pragma unroll
              for (int ks = 0; ks < 2; ++ks)
#pragma unroll
                for (int lt = 0; lt < 4; ++lt) { if (ks == 1 && lt < 2) continue;
                    const bf16x8 mf = *(const LAS bf16x8*)(Mh + (16 * lt + j) * 72 + 32 * ks + 8 * g);
                    yacc[lt] = MFMA16(mf, xf[ks], yacc[lt]); } }
#pragma unroll
            for (int lt = 0; lt < 4; ++lt) { float sq[4];
#pragma unroll
                for (int r = 0; r < 4; ++r) { const int l = 16 * lt + 4 * g + r; float s;
                    { const float z = bf2f(Zw_[l * 24 + j]); const float v = yacc[lt][r] * z; Zw_[l * 24 + j] = (bf16)f2bf(v); s = v * v; }
                    s += __shfl_xor(s, 1); s += __shfl_xor(s, 2); s += __shfl_xor(s, 4); s += __shfl_xor(s, 8); sq[r] = s; }
                if (j == 0) {
#pragma unroll
                    for (int r = 0; r < 4; ++r) ssq[(size_t)(tok0 + 16 * lt + 4 * g + r) * 64] = sq[r]; } }
            LDS_FENCE();
            { bf16* op = pZ + (size_t)(tok0 + lane) * PROJ_LD;
#pragma unroll
              for (int q = 0; q < 2; ++q) *(u32x4*)(op + 8 * q) = *(const LAS u32x4*)(Zw_ + lane * 24 + 8 * q); }
        }
        if (c + 1 < 8) { const size_t o = (size_t)(tok0 + 64 + row) * PROJ_LD + cseg; rB0 = *(const u32x4*)(pB + o); rB1 = *(const u32x4*)(pB + o + 64); if (PASS == 1) { rC0 = *(const u32x4*)(pC + o); rC1 = *(const u32x4*)(pC + o + 64); }
            const size_t ow = (size_t)(tok0 + 64 + lane) * PROJ_LD;
#pragma unroll
            for (int q = 0; q < 2; ++q) { rX[q] = *(const u32x4*)(pX + ow + 8 * q); if (PASS == 1) rZ[q] = *(const u32x4*)(pZ + ow + 8 * q); }
            rdt = dtp[(size_t)(tok0 + 64 + lane) * 16]; }
        { const float dec = __expf(csw[63]);
          bf16x8 xwf[2];
#pragma unroll
          for (int ks = 0; ks < 2; ++ks) { float wsv[8];
              { const f32x4 w0 = *(const LAS f32x4*)(ww + 32 * ks + 8 * g), w1 = *(const LAS f32x4*)(ww + 32 * ks + 8 * g + 4);
#pragma unroll
                for (int e = 0; e < 4; ++e) { wsv[e] = w0[e]; wsv[4 + e] = w1[e]; } }
              { const bf16x8 x8 = tr_frag(Xw_, 24, 32 * ks, 0, lane); float xv[8]; unpack8(__builtin_bit_cast(u32x4, x8), xv);
#pragma unroll
                  for (int e = 0; e < 8; ++e) xv[e] *= wsv[e];
                  const u32x4 xw = pack8(xv); xwf[ks] = __builtin_bit_cast(bf16x8, xw); } }
#pragma unroll
          for (int nt = 0; nt < 8; ++nt) { const bf16x8 b0 = tr_frag(Bs, 144, 0, 16 * nt, lane), b1 = tr_frag(Bs, 144, 32, 16 * nt, lane);
              { f32x4 a = sacc[nt] * dec; a = MFMA16(b0, xwf[0], a); a = MFMA16(b1, xwf[1], a); sacc[nt] = a; } } }
        __syncthreads();
    }
    if (PASS == 0) {
#pragma unroll
        for (int nt = 0; nt < 8; ++nt) Sst[sidx0 + (size_t)seg * 2048 + nt * 64] = sacc[nt];
        if (ph == 0 && lane == 0) Sdec[(b * 16 + head) * 8 + seg] = logdec;
    }
}
__device__ __forceinline__ void ssdnorm_phase(Ctx& F, int li, const float* p_nw) {
    bf16* proj = (bf16*)(F.ws + WS_PROJ); const float* ssq = (const float*)(F.ws + WS_SSQ);
    const int gw = F.bid * NWAVES + F.wave, NGW = F.G * NWAVES, lane = F.lane;
    float nw[16];
#pragma unroll
    for (int e = 0; e < 16; ++e) nw[e] = p_nw[li * 1024 + 16 * lane + e];
    for (int m0 = gw * 4; m0 < M; m0 += NGW * 4) {
        u32x4 ra[4], rb[4]; f32x4 sp[4][8];
#pragma unroll
        for (int u = 0; u < 4; ++u) { const bf16* p = proj + (size_t)(m0 + u) * PROJ_LD + C_Z + 16 * lane; ra[u] = *(const u32x4*)p; rb[u] = *(const u32x4*)(p + 8);
            const f32x4* s4 = (const f32x4*)(ssq + (size_t)(m0 + u) * 64 + (lane >> 5) * 32);
#pragma unroll
            for (int q = 0; q < 8; ++q) sp[u][q] = s4[q]; }
#pragma unroll
        for (int u = 0; u < 4; ++u) { float ssum = 0.f;
#pragma unroll
            for (int q = 0; q < 8; ++q) ssum += (sp[u][q].x + sp[u][q].y) + (sp[u][q].z + sp[u][q].w);
            const float sc = 1.0f / sqrtf(ssum * (1.f / 512.f) + EPS); float x[16];
            unpack8(ra[u], x); unpack8(rb[u], x + 8);
#pragma unroll
            for (int e = 0; e < 16; ++e) x[e] = x[e] * sc * nw[e];
            bf16* p = proj + (size_t)(m0 + u) * PROJ_LD + C_Z + 16 * lane; *(u32x4*)p = pack8(x); *(u32x4*)(p + 8) = pack8(x + 8); }
    }
}
__device__ __forceinline__ void qknorm_phase(Ctx& F, int li, const float* p_qn, const float* p_kn) {
    bf16* qkv = (bf16*)(F.ws + WS_PROJ);
    const int gt = F.bid * NTHREADS + F.tid, NT = F.G * NTHREADS;
    const float L2T = 18.931568569324174f;
    for (int idx = gt; idx < M * 32; idx += NT) {
        const int m = idx >> 5, qk = (idx >> 4) & 1, h = idx & 15;
        bf16* p = qkv + (size_t)m * QKV_LD + qk * 1024 + h * 64;
        const float* gain = (qk ? p_kn : p_qn) + li * 64;
        float x[64]; float ss = 0.f;
#pragma unroll
        for (int q = 0; q < 8; ++q) unpack8(*(const u32x4*)(p + 8 * q), x + 8 * q);
#pragma unroll
        for (int e = 0; e < 64; ++e) ss += x[e] * x[e];
        const float rs = 1.0f / sqrtf(ss * (1.f / 64.f) + EPS);
#pragma unroll
        for (int e = 0; e < 64; ++e) x[e] = x[e] * rs * gain[e];
        const float pos = (float)(m & (SEQ - 1));
#pragma unroll
        for (int i = 0; i < 8; ++i) { const float inv = exp2f(-(float)i * 0.125f * L2T); const float ang = pos * inv;
            double rev = (double)ang * 0.15915494309189535; rev -= floor(rev); const float fr = (float)rev;
            const float sn = __builtin_amdgcn_sinf(fr), cs = __builtin_amdgcn_cosf(fr);
            const float x1 = x[i], x2 = x[i + 8]; x[i] = x1 * cs - x2 * sn; x[i + 8] = x2 * cs + x1 * sn; }
        const float sc = qk ? 1.0f : 0.125f * 1.4426950408889634f;
#pragma unroll
        for (int q = 0; q < 8; ++q) { float y[8];
#pragma unroll
            for (int e = 0; e < 8; ++e) y[e] = x[8 * q + e] * sc;
            *(u32x4*)(p + 8 * q) = pack8(y); }
    }
}
template <int NQT>
__device__ __forceinline__ void attn_first(const bf16* Qp, int d, int r, int qs, int lane, bf16x8 (&qf)[NQT][2], bf16x8 (&kf)[2][2], u32x4 (&v4)[4]) {
    const int j = lane & 15, g = lane >> 4;
#pragma unroll
    for (int qt = 0; qt < NQT; ++qt) { const bf16* qp = Qp + (size_t)(r + d * (qs + 16 * qt + j)) * QKV_LD + 8 * g; qf[qt][0] = *(const bf16x8*)qp; qf[qt][1] = *(const bf16x8*)(qp + 32); }
    const int kstart = qs + 16 * NQT - 160; const int ci0 = kstart < 0 ? (((-kstart) >> 5) < 4 ? ((-kstart) >> 5) : 4) : 0; const int kc = kstart + 32 * ci0;
#pragma unroll
    for (int tt = 0; tt < 2; ++tt) { int kidx = kc + 8 * (j >> 2) + 4 * tt + (j & 3); kidx = kidx < 0 ? 0 : kidx;
        const bf16* kp = Qp + 1024 + (size_t)(r + d * kidx) * QKV_LD + 8 * g; kf[tt][0] = *(const bf16x8*)kp; kf[tt][1] = *(const bf16x8*)(kp + 32); }
    { int kv = kc + (lane >> 1); kv = kv < 0 ? 0 : kv; const bf16* vp = Qp + 2048 + (size_t)(r + d * kv) * QKV_LD + (lane & 1) * 32;
#pragma unroll
      for (int q4 = 0; q4 < 4; ++q4) v4[q4] = *(const u32x4*)(vp + 8 * q4); }
}
template <int NQT, int MODE, int NQTN>
__device__ __forceinline__ void attn_run(const bf16x8 (&qfI)[NQT][2], const bf16x8 (&kfI)[2][2], const u32x4 (&v4I)[4],
                                         bf16x8 (&qfN)[NQTN ? NQTN : 1][2], bf16x8 (&kfN)[2][2], u32x4 (&v4N)[4], int d2, int r2, int qs2,
                                         const bf16* Qp, bf16* Op, int d, int r, int qs, int qloc0,
                                         LAS bf16* Vt, LAS float* Oacc, LAS float* Lb, int lane, const float negc) {
    const int j = lane & 15, g = lane >> 4;
    bf16x8 qf[NQT][2];
#pragma unroll
    for (int qt = 0; qt < NQT; ++qt) { qf[qt][0] = qfI[qt][0]; qf[qt][1] = qfI[qt][1]; }
    f32x4 o[NQT][4]; float lrun[NQT];
#pragma unroll
    for (int qt = 0; qt < NQT; ++qt) { lrun[qt] = 0.f;
#pragma unroll
        for (int dt = 0; dt < 4; ++dt) o[qt][dt] = (f32x4){0.f, 0.f, 0.f, 0.f}; }
    const int kstart = qs + 16 * NQT - 160;
    bf16x8 nkf[2][2]; u32x4 nv4[4];
#define ATT_LOAD(kc_) do { \
        _Pragma("unroll") for (int tt = 0; tt < 2; ++tt) { int kidx = (kc_) + 8 * (j >> 2) + 4 * tt + (j & 3); kidx = kidx < 0 ? 0 : kidx; \
            const bf16* kp = Qp + 1024 + (size_t)(r + d * kidx) * QKV_LD + 8 * g; nkf[tt][0] = *(const bf16x8*)kp; nkf[tt][1] = *(const bf16x8*)(kp + 32); } \
        { int kv = (kc_) + (lane >> 1); kv = kv < 0 ? 0 : kv; const bf16* vp = Qp + 2048 + (size_t)(r + d * kv) * QKV_LD + (lane & 1) * 32; \
          _Pragma("unroll") for (int q4 = 0; q4 < 4; ++q4) nv4[q4] = *(const u32x4*)(vp + 8 * q4); } } while (0)
    const int ci0 = kstart < 0 ? (((-kstart) >> 5) < 4 ? ((-kstart) >> 5) : 4) : 0;
#pragma unroll
    for (int tt = 0; tt < 2; ++tt) { nkf[tt][0] = kfI[tt][0]; nkf[tt][1] = kfI[tt][1]; }
#pragma unroll
    for (int q4 = 0; q4 < 4; ++q4) nv4[q4] = v4I[q4];
    for (int ci = ci0; ci < 5; ++ci) {
        const int kc = kstart + 32 * ci;
        bf16x8 kf[2][2];
#pragma unroll
        for (int tt = 0; tt < 2; ++tt) { kf[tt][0] = nkf[tt][0]; kf[tt][1] = nkf[tt][1]; }
        { u32x4 v4[4];
#pragma unroll
          for (int q4 = 0; q4 < 4; ++q4) v4[q4] = nv4[q4];
          if (ci + 1 < 5) ATT_LOAD(kc + 32);
          LDS_FENCE();
#pragma unroll
          for (int q4 = 0; q4 < 4; ++q4) *(LAS u32x4*)(Vt + (lane >> 1) * 72 + (lane & 1) * 32 + 8 * q4) = v4[q4]; }
        LDS_FENCE();
        bf16x8 vf[4];
#pragma unroll
        for (int dt = 0; dt < 4; ++dt) vf[dt] = tr_frag(Vt, 72, 0, 16 * dt, lane);
        const bool need_mask = (ci == 0) || (ci == 4) || (kc < 0);
#pragma unroll
        for (int qt = 0; qt < NQT; ++qt) {
            f32x4 s0 = (f32x4){negc, negc, negc, negc}, s1 = s0;
            s0 = MFMA16(kf[0][0], qf[qt][0], s0); s0 = MFMA16(kf[0][1], qf[qt][1], s0);
            s1 = MFMA16(kf[1][0], qf[qt][0], s1); s1 = MFMA16(kf[1][1], qf[qt][1], s1);
            float sv[8] = {s0[0], s0[1], s0[2], s0[3], s1[0], s1[1], s1[2], s1[3]};
            float pp[8], psum = 0.f;
#pragma unroll
            for (int e = 0; e < 8; ++e) pp[e] = __builtin_amdgcn_exp2f(sv[e]);
            if (need_mask) {
                const int qi = qs + 16 * qt + j;
#pragma unroll
                for (int e = 0; e < 8; ++e) { const int kidx = kc + 8 * g + e; const int diff = qi - kidx; const bool ok = (kidx >= 0) && (diff >= 0) && (diff <= 128); pp[e] = ok ? pp[e] : 0.f; }
            }
#pragma unroll
            for (int e = 0; e < 8; ++e) psum += pp[e];
            lrun[qt] += psum;
            const u32x4 pw = pack8(pp); const bf16x8 pf = __builtin_bit_cast(bf16x8, pw);
#pragma unroll
            for (int dt = 0; dt < 4; ++dt) o[qt][dt] = MFMA16(vf[dt], pf, o[qt][dt]);
        }
    }
    if (NQTN > 0) attn_first<(NQTN ? NQTN : 1)>(Qp, d2, r2, qs2, lane, qfN, kfN, v4N);
#pragma unroll
    for (int qt = 0; qt < NQT; ++qt) {
        float l = lrun[qt]; l += __shfl_xor(l, 16); l += __shfl_xor(l, 32);
        const int qloc = qloc0 + d * (16 * qt + j);
        if (MODE == 0) {
#pragma unroll
            for (int dt = 0; dt < 4; ++dt) *(LAS f32x4*)(Oacc + qloc * 68 + 16 * dt + 4 * g) = o[qt][dt];
            if (g == 0) Lb[qloc] = l;
        } else {
            const float ln = Lb[qloc] + l;
            LDS_FENCE();
            if (MODE == 1) {
#pragma unroll
                for (int dt = 0; dt < 4; ++dt) { LAS f32x4* p4 = (LAS f32x4*)(Oacc + qloc * 68 + 16 * dt + 4 * g); *p4 = *p4 + o[qt][dt]; }
                if (g == 0) Lb[qloc] = ln;
            } else {
                const float inv = 1.0f / ln; bf16* op = Op + (size_t)(r + d * (qs + 16 * qt + j)) * QKV_LD;
#pragma unroll
                for (int dt = 0; dt < 4; ++dt) { float y[4]; const f32x4 a4 = *(const LAS f32x4*)(Oacc + qloc * 68 + 16 * dt + 4 * g);
#pragma unroll
                    for (int rr = 0; rr < 4; ++rr) y[rr] = (a4[rr] + o[qt][dt][rr]) * inv;
                    u32x2 w; w.x = pk2(y[0], y[1]); w.y = pk2(y[2], y[3]); *(u32x2*)(op + 16 * dt + 4 * g) = w; }
            }
        }
    }
    LDS_FENCE();
#undef ATT_LOAD
}
__device__ __forceinline__ void attn_item(Ctx& F, int b, int h, int blk, const float negc) {
    bf16* base = (bf16*)(F.ws + WS_PROJ) + (size_t)b * SEQ * QKV_LD + h * 64;
    const bf16* Qp = base;
    const int wave = F.wave, lane = F.lane, T0 = blk * 256;
    bf16* Ob = base;
    LAS bf16* Vt = (LAS bf16*)(F.lds + wave * 5120);
    LAS float* Oacc = (LAS float*)(F.lds + 40960); LAS float* Lb = Oacc + 256 * 68;
    bf16x8 qA[2][2], kA[2][2]; u32x4 vA[4]; attn_first<2>(Qp, 1, 0, T0 + 32 * wave, lane, qA, kA, vA);
    bf16x8 qB[2][2], kB[2][2]; u32x4 vB[4];
    attn_run<2, 0, 2>(qA, kA, vA, qB, kB, vB, 4, wave >> 1, T0 / 4 + 32 * (wave & 1), Qp, Ob, 1, 0, T0 + 32 * wave, 32 * wave, Vt, Oacc, Lb, lane, negc);
    __syncthreads();
    bf16x8 qC[1][2], kC[2][2]; u32x4 vC[4];
    attn_run<2, 1, 1>(qB, kB, vB, qC, kC, vC, 16, 2 * wave, T0 / 16, Qp, Ob, 4, wave >> 1, T0 / 4 + 32 * (wave & 1), (wave >> 1) + 128 * (wave & 1), Vt, Oacc, Lb, lane, negc);
    __syncthreads();
    bf16x8 qD[1][2], kD[2][2]; u32x4 vD[4];
    attn_run<1, 2, 1>(qC, kC, vC, qD, kD, vD, 16, 2 * wave + 1, T0 / 16, Qp, Ob, 16, 2 * wave, T0 / 16, 2 * wave, Vt, Oacc, Lb, lane, negc);
    bf16x8 qE[1][2], kE[2][2]; u32x4 vE[4];
    attn_run<1, 2, 0>(qD, kD, vD, qE, kE, vE, 0, 0, 0, Qp, Ob, 16, 2 * wave + 1, T0 / 16, 2 * wave + 1, Vt, Oacc, Lb, lane, negc);
    __syncthreads();
}
#define XB_TMO      128
#define XB_XCNT(j)  (256  + 64 * (j))
#define XB_XSUB(j)  (1280 + 64 * (j))
#define XB_XGEN(j)  (2304 + 64 * (j))
#define XB_TOP      3328
#define XB_TOPGEN   3392
#define XCD_BAR_WORDS 3456
#define XB_SPIN_CAP (1u << 18)

__device__ __forceinline__ unsigned xb_ld(unsigned* p)              { return __hip_atomic_load(p, __ATOMIC_RELAXED, __HIP_MEMORY_SCOPE_AGENT); }
__device__ __forceinline__ unsigned xb_add(unsigned* p, unsigned v) { return __hip_atomic_fetch_add(p, v, __ATOMIC_RELAXED, __HIP_MEMORY_SCOPE_AGENT); }
__device__ __forceinline__ unsigned xb_xcc_id() { return (unsigned)__builtin_amdgcn_s_getreg((3 << 11) | 20) & 0xFu; }
#define XB_SPIN(cond, bar) do { unsigned _sp = 0; while (cond) { __builtin_amdgcn_s_sleep(1); \
    if ((++_sp & 255u) == 0u) { if (xb_ld(&(bar)[XB_TMO])) break; if (_sp > XB_SPIN_CAP) { atomicAdd(&(bar)[XB_TMO], 1u); break; } } } } while (0)

struct XcdBarrier {
    unsigned* bar; unsigned x;
    volatile LAS unsigned* st;
};

__device__ __forceinline__ XcdBarrier xcd_barrier_post(unsigned* bar, volatile LAS unsigned* st) {
    XcdBarrier b; b.bar = bar; b.x = xb_xcc_id(); b.st = st;
    if (threadIdx.x == 0) (void)xb_add(&bar[XB_XCNT(b.x)], 1u);
    return b;
}
__device__ __forceinline__ void xcd_barrier_complete(unsigned* bar, unsigned x, unsigned& nloc, unsigned& nx) {
    const unsigned G = gridDim.x * gridDim.y * gridDim.z;
    unsigned sum, cnt, mine, sp = 0u;
    for (;;) {
        sum = 0u; cnt = 0u; mine = 0u;
#pragma unroll
        for (unsigned j = 0; j < 16; ++j) { const unsigned c = xb_ld(&bar[XB_XCNT(j)]); sum += c; cnt += (c > 0u) ? 1u : 0u; mine = (j == x) ? c : mine; }
        if (sum == G) break;
        __builtin_amdgcn_s_sleep(1);
        if ((++sp & 255u) == 0u) { if (xb_ld(&bar[XB_TMO])) break; if (sp > XB_SPIN_CAP) { atomicAdd(&bar[XB_TMO], 1u); break; } }
    }
    nloc = mine > 0u ? mine : 1u; nx = cnt > 0u ? cnt : 1u;
}

__device__ __forceinline__ void xcd_barrier(const XcdBarrier& b) {
    asm volatile("s_waitcnt vmcnt(0)" ::: "memory");
    __syncthreads();
    if (threadIdx.x == 0) {
        unsigned* bar = b.bar;
        __builtin_amdgcn_s_waitcnt(0);
        unsigned nloc = b.st[0], nx = b.st[1];
        if (nloc == 0u) { xcd_barrier_complete(bar, b.x, nloc, nx); b.st[0] = nloc; b.st[1] = nx; }
        const unsigned old = xb_add(&bar[XB_XSUB(b.x)], 1u);
        const unsigned gen = old / nloc;
        if (old + 1u == (gen + 1u) * nloc) {
            __builtin_amdgcn_fence(__ATOMIC_RELEASE, "agent");
            asm volatile("s_waitcnt vmcnt(0)" ::: "memory");
            const unsigned og = xb_add(&bar[XB_TOP], 1u);
            const unsigned tg = og / nx;
            if (og + 1u == (tg + 1u) * nx) xb_add(&bar[XB_TOPGEN], 1u);
            else XB_SPIN(xb_ld(&bar[XB_TOPGEN]) == tg, bar);
            __builtin_amdgcn_fence(__ATOMIC_ACQUIRE, "agent");
            xb_add(&bar[XB_XGEN(b.x)], 1u);
            asm volatile("s_waitcnt vmcnt(0)" ::: "memory");
        } else {
            XB_SPIN(xb_ld(&bar[XB_XGEN(b.x)]) == gen, bar);
            __builtin_amdgcn_fence(__ATOMIC_ACQUIRE, "agent");
            asm volatile("s_waitcnt vmcnt(0)" ::: "memory");
        }
    }
    __syncthreads();
}

constexpr int BAR_ST_OFF = LDS_BYTES - 64;
struct Args { const float* in[25]; float* out; unsigned char* ws; int ph_lo, ph_hi; };
static_assert(sizeof(Args) == 224, "Args layout");
#ifndef PG8_SP2
#define PG8_SP2 true
#endif
#ifndef PG8_ALIGN
#define PG8_ALIGN true
#endif
__device__ __forceinline__ void rs_prologue(Ctx& F, const pg8::StaticOrder& S) {
    LAS float* rsl = (LAS float*)(F.lds + 131072); LAS int* pmt = (LAS int*)(F.lds + 131072 + 4096);
    int p0 = -1, p1 = -1, p2 = -1, p3 = -1; pg8::Unit u;
    for (int i = 0; S.next(i, u); ++i) { const int pm = u.pm; if (pm == p0 || pm == p1 || pm == p2 || pm == p3) continue;
        if (p0 < 0) p0 = pm; else if (p1 < 0) p1 = pm; else if (p2 < 0) p2 = pm; else if (p3 < 0) p3 = pm; }
    const float* rs = (const float*)(F.ws + WS_RS);
#pragma unroll
    for (int q = 0; q < 2; ++q) { const int idx = F.tid + 512 * q, slot = idx >> 8, r = idx & 255; const int pm = slot == 0 ? p0 : slot == 1 ? p1 : slot == 2 ? p2 : p3;
        if (pm >= 0) rsl[idx] = pg8::row_rs(rs, pm * 256 + r); }
    if (F.tid == 0) { pmt[0] = p0; pmt[1] = p1; pmt[2] = p2; pmt[3] = p3; }
    __syncthreads();
}
__device__ __forceinline__ void gemm_proj(Ctx& F, const bf16* A, int lda, const bf16* Bt, int N, int K, bf16* O, int ldc, float* dt, int dt_pn) {
    const float* rs = (const float*)(F.ws + WS_RS); bf16* halo = dt ? (bf16*)(F.ws + WS_HALO) : nullptr;
    pg8::Gemm g{A, Bt, M, N, K, lda}; pg8::StaticOrder S; S.init(M, N, F.G, F.bid);
    rs_prologue(F, S);
    pg8::EpiProj E{F.lds + 131072, O, ldc, dt, dt_pn, rs, halo};
    pg8::gemm_phase<pg8::EpiProj, pg8::StaticOrder, PG8_ALIGN, PG8_SP2>(F.lds, g, S, E, F.tid);
}
__device__ __forceinline__ void gemm_qkv(Ctx& F, const bf16* A, const bf16* Bt, bf16* O, const float* gq, const float* gk) {
    pg8::Gemm g{A, Bt, M, QKV_LD, DM, DM}; pg8::StaticOrder S; S.init(M, QKV_LD, F.G, F.bid);
    rs_prologue(F, S);
    pg8::EpiQKV E{F.lds + 131072, O, QKV_LD, (const float*)(F.ws + WS_RS), gq, gk};
    pg8::gemm_phase<pg8::EpiQKV, pg8::StaticOrder, PG8_ALIGN, PG8_SP2>(F.lds, g, S, E, F.tid);
}
__device__ __forceinline__ void gemm_swiglu(Ctx& F, const bf16* A, const bf16* Bt, bf16* O) {
    pg8::Gemm g{A, Bt, M, GU_N, DM, DM}; pg8::StaticOrder S; S.init(M, GU_N, F.G, F.bid);
    rs_prologue(F, S);
    pg8::EpiSwiglu E{F.lds + 131072, O, FFN_H, (const float*)(F.ws + WS_RS)};
    pg8::gemm_phase<pg8::EpiSwiglu, pg8::StaticOrder, PG8_ALIGN, PG8_SP2>(F.lds, g, S, E, F.tid);
}
__device__ __forceinline__ void gemm_res(Ctx& F, const bf16* A, int lda, const bf16* Bt, int K, const float* basef, float* outf) {
    pg8::Gemm g{A, Bt, M, DM, K, lda}; pg8::StaticOrder S; S.init(M, DM, F.G, F.bid);
    pg8::EpiRes E{basef, outf, DM, (bf16*)(F.ws + WS_H), (float*)(F.ws + WS_RS)};
    pg8::gemm_phase<pg8::EpiRes, pg8::StaticOrder, PG8_ALIGN, PG8_SP2>(F.lds, g, S, E, F.tid);
}

__global__ void __launch_bounds__(NTHREADS, 2) trunk_fwd(Args args) {
    extern __shared__ __attribute__((aligned(16))) unsigned char lds_raw[];
    cg::grid_group grid = cg::this_grid();
    Ctx F;
    F.lds = (LAS unsigned char*)lds_raw; F.tid = threadIdx.x; F.lane = F.tid & 63; F.wave = __builtin_amdgcn_readfirstlane(F.tid >> 6); F.G = gridDim.x; F.bid = blockIdx.x;
#define Hb ((bf16*)(F.ws + WS_H))
#define PJ ((bf16*)(F.ws + WS_PROJ))
#define KAS __attribute__((address_space(4)))
#define KIN(k) (*(const float* KAS const*)(karg + 8 * (k)))
    KAS unsigned char* karg0 = (KAS unsigned char*)__builtin_amdgcn_kernarg_segment_ptr();
#ifdef PROBE_MASK
    unsigned long long pt_prev = __builtin_amdgcn_s_memrealtime(), pt_acc = 0ull;
#define PROBE_STAMP() do { const unsigned long long t_ = __builtin_amdgcn_s_memrealtime(); if ((PROBE_MASK >> pk_) & 1) pt_acc += t_ - pt_prev; pt_prev = t_; } while (0)
#else
#define PROBE_STAMP() do {} while (0)
#endif
    int pk_ = 0;
    if (threadIdx.x < 16) ((LAS unsigned*)(F.lds + BAR_ST_OFF))[threadIdx.x] = 0u;
    __syncthreads();
    const int lo = *(KAS const int*)(karg0 + 216), hi = *(KAS const int*)(karg0 + 220); int ph = 0;
#define PHASE_BEGIN_K(kind) pk_ = (kind); if (ph >= lo && ph < hi) { KAS unsigned char* karg = karg0; { int t_ = threadIdx.x, b_ = blockIdx.x, g_ = gridDim.x; asm volatile("" : "+s"(karg), "+v"(t_), "+s"(b_), "+s"(g_)); F.ws = *(unsigned char* KAS const*)(karg + 208); F.out = *(float* KAS const*)(karg + 200); F.tid = t_; F.lane = t_ & 63; F.wave = __builtin_amdgcn_readfirstlane(t_ >> 6); F.bid = b_; F.G = g_; }
#define PHASE_END if (ph + 1 < hi) { asm volatile("s_waitcnt vmcnt(0) lgkmcnt(0)" ::: "memory"); if (ph == 0) { grid.sync(); __builtin_amdgcn_fence(__ATOMIC_ACQUIRE, "agent"); asm volatile("s_waitcnt vmcnt(0)" ::: "memory"); __syncthreads(); (void)xcd_barrier_post((unsigned*)(F.ws + WS_CTL), (volatile LAS unsigned*)(F.lds + BAR_ST_OFF)); } else { XcdBarrier xb_; xb_.bar = (unsigned*)(F.ws + WS_CTL); xb_.x = xb_xcc_id(); xb_.st = (volatile LAS unsigned*)(F.lds + BAR_ST_OFF); xcd_barrier(xb_); } PROBE_STAMP(); } } ++ph;

    PHASE_BEGIN_K(0) if (F.bid == 0) { for (int i = F.tid; i < XCD_BAR_WORDS; i += NTHREADS) ((unsigned*)(F.ws + WS_CTL))[i] = 0u; }
        p0_weights(F, KIN(2), KIN(16), KIN(18), KIN(21), KIN(23), KIN(24), KIN(5), KIN(7), KIN(1), KIN(17), KIN(22), KIN(0)); PHASE_END
#pragma unroll 1
    for (int layer = 0; layer < DEPTH; ++layer) {
        const int li = layer >> 1;

        if ((layer & 1) == 0) {
            PHASE_BEGIN_K(2)
                gemm_proj(F, Hb, DM, (const bf16*)(F.ws + W_REC_IN + li * SZ_REC_IN), 4608, DM, PJ, PROJ_LD, (float*)(F.ws + WS_DT), -1);
            PHASE_END
            PHASE_BEGIN_K(4) conv_phase(F, li, KIN(3), KIN(4), KIN(10), KIN(11)); PHASE_END
            PHASE_BEGIN_K(5)
                if (F.G >= 256) { if (F.bid < 128) { lru_item(F, li, F.bid >> 4, F.bid & 15, KIN(6), KIN(8), KIN(9)); }
                                  else for (int it = F.bid - 128; it < 512; it += F.G - 128) { ssd_seg_item<0>(F, li, it >> 6, (it >> 3) & 7, it & 7, KIN(12), KIN(13), KIN(14)); __syncthreads(); } }
                else for (int it = F.bid; it < 640; it += F.G) { if (it < 128) lru_item(F, li, it >> 4, it & 15, KIN(6), KIN(8), KIN(9)); else ssd_seg_item<0>(F, li, (it - 128) >> 6, ((it - 128) >> 3) & 7, (it - 128) & 7, KIN(12), KIN(13), KIN(14)); __syncthreads(); }
            PHASE_END
            PHASE_BEGIN_K(5)
                for (int it = F.bid, k_ = 0; it < 512; it += F.G, ++k_) { const int sg_ = (k_ & 1) ? 7 - (it & 7) : (it & 7); ssd_seg_item<1>(F, li, it >> 6, (it >> 3) & 7, sg_, KIN(12), KIN(13), KIN(14)); __syncthreads(); }
            PHASE_END
            PHASE_BEGIN_K(6) ssdnorm_phase(F, li, KIN(15)); PHASE_END
            PHASE_BEGIN_K(7)
                gemm_res(F, PJ + C_GATE, PROJ_LD, (const bf16*)(F.ws + W_REC_OUT + li * SZ_REC_OUT), REC_OUT, (layer == 0) ? KIN(0) : nullptr, nullptr);
            PHASE_END
        } else {
            PHASE_BEGIN_K(8) gemm_qkv(F, Hb, (const bf16*)(F.ws + W_QKV + li * SZ_QKV), PJ, KIN(19) + li * 64, KIN(20) + li * 64); PHASE_END
            PHASE_BEGIN_K(10)
#ifdef PROBE_REP_ATTN
                float negc_; { float gq = fabsf(KIN(19)[li * 64 + F.lane]), gk = fabsf(KIN(20)[li * 64 + F.lane]);
#pragma unroll
                  for (int o_ = 1; o_ < 64; o_ <<= 1) { gq = fmaxf(gq, __shfl_xor(gq, o_)); gk = fmaxf(gk, __shfl_xor(gk, o_)); }
                  negc_ = -(8.0f * 1.4426950408889634f) * gq * gk; }
                for (int it = F.bid; it < BATCH * 16 * 16; it += F.G) { int h_ = (it >> 4) & 15, blk_ = it & 15; if (F.G == 256) { const int x_ = F.bid & 7, m_ = F.bid >> 3; h_ = 2 * x_ + (m_ >> 4); blk_ = ((m_ & 15) + 2 * (it >> 8)) & 15; }
                    attn_item(F, it >> 8, h_, blk_, negc_); }
#endif
                float negc_; { float gq = fabsf(KIN(19)[li * 64 + F.lane]), gk = fabsf(KIN(20)[li * 64 + F.lane]);
#pragma unroll
                  for (int o_ = 1; o_ < 64; o_ <<= 1) { gq = fmaxf(gq, __shfl_xor(gq, o_)); gk = fmaxf(gk, __shfl_xor(gk, o_)); }
                  negc_ = -(8.0f * 1.4426950408889634f) * gq * gk; }
                for (int it = F.bid; it < BATCH * 16 * 16; it += F.G) { int h_ = (it >> 4) & 15, blk_ = it & 15; if (F.G == 256) { const int x_ = F.bid & 7, m_ = F.bid >> 3; h_ = 2 * x_ + (m_ >> 4); blk_ = ((m_ & 15) + 2 * (it >> 8)) & 15; }
                    attn_item(F, it >> 8, h_, blk_, negc_); }
            PHASE_END
            PHASE_BEGIN_K(11) gemm_res(F, PJ, QKV_LD, (const bf16*)(F.ws + W_ATT_OUT + li * SZ_ATT_OUT), DM, nullptr, nullptr); PHASE_END
        }
#ifdef PROBE_REP_GU
#pragma unroll 1
        for (int rep = 0; rep < 2; ++rep) { --ph;
        PHASE_BEGIN_K(12) gemm_swiglu(F, Hb, (const bf16*)(F.ws + W_GU + layer * SZ_GU), PJ); PHASE_END
        } ++ph;
#else
        PHASE_BEGIN_K(12) gemm_swiglu(F, Hb, (const bf16*)(F.ws + W_GU + layer * SZ_GU), PJ); PHASE_END
#endif
        PHASE_BEGIN_K(13) gemm_res(F, PJ, FFN_H, (const bf16*)(F.ws + W_DOWN + layer * SZ_DOWN), FFN_H, nullptr, (layer == DEPTH - 1) ? F.out : nullptr); PHASE_END
    }
#ifdef PROBE_MASK
    { asm volatile("s_waitcnt vmcnt(0) lgkmcnt(0)" ::: "memory"); grid.sync(); const unsigned long long t_ = __builtin_amdgcn_s_memrealtime(); if ((PROBE_MASK >> pk_) & 1) pt_acc += t_ - pt_prev;
      if (blockIdx.x == 0 && threadIdx.x == 0) { float* o_ = *(float* KAS const*)(karg0 + 200); o_[0] += (float)pt_acc * 0.01f; } }
#endif
}
constexpr int N_PHASES = 1 + 2 * 8 + 2 * 5;

extern "C" void kernel_launch(void* const* d_in, const int* in_sizes, int n_in, void* d_out, int out_size, void* d_ws, size_t ws_size, hipStream_t stream) {
    static int grid = 0;
    if (grid == 0) {
        if (n_in != 25 || in_sizes[0] != M * DM || out_size != M * DM || ws_size < WS_END) { fprintf(stderr, "kernel_launch: unexpected shapes (n_in %d, in0 %d, out %d, ws %zu)\n", n_in, n_in > 0 ? in_sizes[0] : -1, out_size, ws_size); grid = -1; return; }
        int dev = 0, cus = 0, per_cu = 0;
        (void)hipGetDevice(&dev); (void)hipDeviceGetAttribute(&cus, hipDeviceAttributeMultiprocessorCount, dev);
        if (hipFuncSetAttribute((const void*)trunk_fwd, hipFuncAttributeMaxDynamicSharedMemorySize, LDS_BYTES) != hipSuccess) { fprintf(stderr, "kernel_launch: hipFuncSetAttribute failed\n"); grid = -1; return; }
        if (hipOccupancyMaxActiveBlocksPerMultiprocessor(&per_cu, (const void*)trunk_fwd, NTHREADS, LDS_BYTES) != hipSuccess || per_cu < 1) { fprintf(stderr, "kernel_launch: occupancy query says %d\n", per_cu); per_cu = 1; }
        (void)hipGetLastError();
        grid = cus * 1;
        fprintf(stderr, "kernel_launch: grid %d (cus %d, per_cu %d)\n", grid, cus, per_cu);
    }
    if (grid < 0) return;
    Args a{};
    for (int i = 0; i < 25; ++i) a.in[i] = (const float*)d_in[i];
    a.out = (float*)d_out; a.ws = (unsigned char*)d_ws; a.ph_lo = 0; a.ph_hi = N_PHASES;
    void* kargs[] = {&a};
    hipError_t e = hipLaunchCooperativeKernel((const void*)trunk_fwd, dim3(grid), dim3(NTHREADS), kargs, LDS_BYTES, stream);
    if (e != hipSuccess) fprintf(stderr, "kernel_launch: cooperative launch failed: %s (grid %d)\n", hipGetErrorString(e), grid);
}
```

```cpp
#include <hip/hip_runtime.h>
#include <hip/hip_cooperative_groups.h>
#include <cstdio>
#include <cstdint>
namespace cg = cooperative_groups;
namespace pg8 {
#define PG8_LAS __attribute__((address_space(3)))
typedef unsigned short bf16_t;
typedef short bf16x8 __attribute__((ext_vector_type(8)));
typedef float f32x4 __attribute__((ext_vector_type(4)));
typedef unsigned u32x4 __attribute__((ext_vector_type(4)));
constexpr int BM = 256, BK = 64, HALF = 128, HTB = HALF * BK * 2  , STAGE_BYTES = 8 * HTB, NXCD = 8, WGM = 8;

__host__ __device__ __forceinline__ int lds_byte(int r, int c) { const int st = (r >> 4) * 2 + (c >> 5), rr = r & 15, cc = c & 31, ob = rr * 64 + cc * 2; return st * 1024 + (ob ^ (((ob >> 9) & 1) << 5)); }
__host__ __device__ __forceinline__ void stage_rc(int b, int& R, int& C) { const int st = b / 1024, sb = b % 1024, swz = sb ^ (((sb >> 9) & 1) << 5); R = (st >> 1) * 16 + swz / 64; C = (st & 1) * 32 + (swz % 64) / 2; }
__host__ __device__ __forceinline__ int perm32(int rho) { const int n = rho >> 4, i = rho & 15; return 8 * (i >> 2) + 4 * n + (i & 3); }

struct Unit { int pm, pn; };
struct Gemm { const bf16_t* A; const bf16_t* Bt; int M, N, K, lda; };

struct StaticOrder {
    int nM, nN, nwg, G, c;
    __host__ __device__ void init(int M, int N, int G_, int c_) { nM = M / BM; nN = N / BM; nwg = nM * nN; G = G_; c = c_; }
    __host__ __device__ bool next(int i, Unit& u) const {
        const long L = (long)i * G + c; if (L >= nwg) return false;
        int wgid = (int)L; { const int q = nwg / NXCD, r = nwg % NXCD, xcd = wgid % NXCD, off = wgid / NXCD; wgid = (xcd < r ? xcd * (q + 1) : r * (q + 1) + (xcd - r) * q) + off; }
        const int nig = WGM * nN, gid = wgid / nig, fm = gid * WGM, gsz = (nM - fm) < WGM ? (nM - fm) : WGM;
        u.pm = fm + ((wgid % nig) % gsz); u.pn = (wgid % nig) / gsz; return true;
    }
    __device__ __forceinline__ void a_ready(const Unit&) const {}
    __device__ __forceinline__ void done(const Unit&) const {}
};

__device__ __forceinline__ unsigned cvt_pk_bf16(float lo, float hi) { unsigned r; asm volatile("v_cvt_pk_bf16_f32 %0, %1, %2" : "=v"(r) : "v"(lo), "v"(hi)); return r; }
typedef float f32x2 __attribute__((ext_vector_type(2)));
__device__ __forceinline__ float fast_exp(float x) { return __builtin_amdgcn_exp2f(x * 1.4426950408889634f); }
__device__ __forceinline__ float fast_sigmoid(float x) { return __builtin_amdgcn_rcpf(1.0f + fast_exp(-x)); }
__device__ __forceinline__ float fast_silu(float x) { return x * fast_sigmoid(x); }

__device__ __forceinline__ float row_rs(const float* rs, int row) {
    const f32x4* p = (const f32x4*)(rs + (size_t)row * 16); const f32x4 a = p[0], b = p[1], c = p[2], d = p[3];
    const float s = ((a[0] + a[1]) + (a[2] + a[3])) + ((b[0] + b[1]) + (b[2] + b[3])) + ((c[0] + c[1]) + (c[2] + c[3])) + ((d[0] + d[1]) + (d[2] + d[3]));
    return 1.0f / sqrtf(s * (1.0f / 1024.0f) + 1e-6f);
}
struct RsView { const PG8_LAS float* p; bool hit; };
__device__ __forceinline__ RsView rs_view(PG8_LAS unsigned char* ldsx, int pm) {
    const PG8_LAS int* pmt = (const PG8_LAS int*)(ldsx + 4096); const PG8_LAS float* t = (const PG8_LAS float*)ldsx; RsView v; v.hit = true;
    if (pmt[0] == pm) v.p = t; else if (pmt[1] == pm) v.p = t + 256; else if (pmt[2] == pm) v.p = t + 512; else if (pmt[3] == pm) v.p = t + 768; else { v.p = t; v.hit = false; }
    return v;
}
#define RS_GET(view, rs, row) ((view).hit ? (view).p[(row) & 255] : row_rs((rs), (row)))
typedef unsigned u32x2v __attribute__((ext_vector_type(2)));
__device__ __forceinline__ float gelu_tanh_e(float x) { const float y = 0.7978845608028654f * (x + 0.044715f * x * x * x); const float e = fast_exp(2.f * y); const float t = 1.f - 2.f * __builtin_amdgcn_rcpf(e + 1.f); return 0.5f * x * (1.f + t); }
struct EpiProj {
    static constexpr bool PERM = true, AFTER_DRAIN = false;
    PG8_LAS unsigned char* ldsx; bf16_t* O; int ldc; float* dt; int dt_pn; const float* rs; bf16_t* halo;
    __device__ __forceinline__ void operator()(const f32x4 (&acc)[2][2][4][2], const Unit& u, int wr, int wc, int fr, int fq) const {
        const int row0 = u.pm * BM + wr * 64 + fr; const int col0 = u.pn * BM + wc * 32 + 8 * fq; const RsView rv = rs_view(ldsx, u.pm);
#pragma unroll
        for (int ai = 0; ai < 2; ++ai)
#pragma unroll
            for (int m = 0; m < 4; ++m) { const int row = row0 + ai * HALF + m * 16; bf16_t* rowp = O + (size_t)row * ldc + col0; const float sc = RS_GET(rv, rs, row);
#pragma unroll
                for (int bj = 0; bj < 2; ++bj) { f32x4 v0 = acc[ai][bj][m][0] * sc, v1 = acc[ai][bj][m][1] * sc;
                    if (dt) { const int cblk = (col0 + bj * HALF) >> 10;
                        if (cblk == 1) {
#pragma unroll
                            for (int e = 0; e < 4; ++e) { v0[e] = gelu_tanh_e(v0[e]); v1[e] = gelu_tanh_e(v1[e]); } }
                        else if (cblk == 2) {
#pragma unroll
                            for (int e = 0; e < 4; ++e) { v0[e] = fast_silu(v0[e]); v1[e] = fast_silu(v1[e]); } } }
                    u32x4 w; w.x = cvt_pk_bf16(v0[0], v0[1]); w.y = cvt_pk_bf16(v0[2], v0[3]); w.z = cvt_pk_bf16(v1[0], v1[1]); w.w = cvt_pk_bf16(v1[2], v1[3]);
                    *(u32x4*)(rowp + bj * HALF) = w;
                    if (halo && m == 3 && fr >= 13) { const int col = col0 + bj * HALF; const int t = row & 4095;
                        if (t < 4032 && (col < 1024 || (col >= 3072 && col < 4608))) { const int gidx = col < 1024 ? (col >> 3) : 128 + ((col - 3072) >> 3);
                            *(u32x4*)(halo + (size_t)(((row >> 12) * 64 + (t >> 6) + 1) * 3 + (fr - 13)) * 2560 + gidx * 8) = w; } } }
                if (u.pn == dt_pn && wc == 0 && fq < 2) { float* dp = dt + (size_t)row * 16 + 8 * fq; *(f32x4*)dp = acc[ai][0][m][0] * sc; *(f32x4*)(dp + 4) = acc[ai][0][m][1] * sc; } }
    }
};

struct EpiQKV {
    static constexpr bool PERM = true, AFTER_DRAIN = false;
    PG8_LAS unsigned char* ldsx; bf16_t* O; int ldc; const float* rs; const float* gq; const float* gk;
    __device__ __forceinline__ void operator()(const f32x4 (&acc)[2][2][4][2], const Unit& u, int wr, int wc, int fr, int fq) const {
        const int row0 = u.pm * BM + wr * 64 + fr; const RsView rv = rs_view(ldsx, u.pm);
        if (u.pn >= 8) {
            const int col0 = u.pn * BM + wc * 32 + 8 * fq;
#pragma unroll
            for (int ai = 0; ai < 2; ++ai)
#pragma unroll
                for (int m = 0; m < 4; ++m) { const int row = row0 + ai * HALF + m * 16; bf16_t* rowp = O + (size_t)row * ldc + col0; const float sc = RS_GET(rv, rs, row);
#pragma unroll
                    for (int bj = 0; bj < 2; ++bj) { const f32x4 v0 = acc[ai][bj][m][0] * sc, v1 = acc[ai][bj][m][1] * sc;
                        u32x4 w; w.x = cvt_pk_bf16(v0[0], v0[1]); w.y = cvt_pk_bf16(v0[2], v0[3]); w.z = cvt_pk_bf16(v1[0], v1[1]); w.w = cvt_pk_bf16(v1[2], v1[3]);
                        *(u32x4*)(rowp + bj * HALF) = w; } }
            return;
        }
        const int region = u.pn >> 2, head = 4 * (u.pn & 3) + wc; const float* gain = region ? gk : gq;
        const float oscale = region ? 1.0f : 0.125f * 1.4426950408889634f;
        const bool rot = fq < 2;
        f32x4 gv[2][2];
#pragma unroll
        for (int bj = 0; bj < 2; ++bj)
#pragma unroll
            for (int n = 0; n < 2; ++n) { const int dbase = (bj == 0 && rot) ? 4 * fq + 8 * n : 32 * bj + 8 * fq + 4 * n; gv[bj][n] = *(const f32x4*)(gain + dbase); }
        float inv[4];
#pragma unroll
        for (int e = 0; e < 4; ++e) inv[e] = exp2f(-(float)(4 * (fq & 1) + e) * 0.125f * 18.931568569324174f);
#pragma unroll
        for (int ai = 0; ai < 2; ++ai)
#pragma unroll
            for (int m = 0; m < 4; ++m) { const int row = row0 + ai * HALF + m * 16; const float sc = RS_GET(rv, rs, row);
                f32x4 v[2][2]; float ss = 0.f;
#pragma unroll
                for (int bj = 0; bj < 2; ++bj)
#pragma unroll
                    for (int n = 0; n < 2; ++n) { v[bj][n] = acc[ai][bj][m][n] * sc; ss += (v[bj][n][0] * v[bj][n][0] + v[bj][n][1] * v[bj][n][1]) + (v[bj][n][2] * v[bj][n][2] + v[bj][n][3] * v[bj][n][3]); }
                ss += __shfl_xor(ss, 16); ss += __shfl_xor(ss, 32);
                const float rn = 1.0f / sqrtf(ss * (1.0f / 64.0f) + 1e-6f);
#pragma unroll
                for (int bj = 0; bj < 2; ++bj)
#pragma unroll
                    for (int n = 0; n < 2; ++n) v[bj][n] = v[bj][n] * rn * gv[bj][n];
                if (rot) { const float pos = (float)(row & 4095);
#pragma unroll
                    for (int e = 0; e < 4; ++e) { const float ang = pos * inv[e]; double rev = (double)ang * 0.15915494309189535; rev -= floor(rev); const float frv = (float)rev;
                        const float sn = __builtin_amdgcn_sinf(frv), cs = __builtin_amdgcn_cosf(frv); const float x1 = v[0][0][e], x2 = v[0][1][e];
                        v[0][0][e] = x1 * cs - x2 * sn; v[0][1][e] = x2 * cs + x1 * sn; } }
                bf16_t* rowp = O + (size_t)row * ldc + region * 1024 + head * 64 + 8 * fq;
#pragma unroll
                for (int bj = 0; bj < 2; ++bj) { const f32x4 v0 = v[bj][0] * oscale, v1 = v[bj][1] * oscale;
                    u32x4 w; w.x = cvt_pk_bf16(v0[0], v0[1]); w.y = cvt_pk_bf16(v0[2], v0[3]); w.z = cvt_pk_bf16(v1[0], v1[1]); w.w = cvt_pk_bf16(v1[2], v1[3]);
                    *(u32x4*)(rowp + bj * 32) = w; } }
    }
};
struct EpiSwiglu {
    static constexpr bool PERM = true, AFTER_DRAIN = false;
    PG8_LAS unsigned char* ldsx; bf16_t* O; int ldc; const float* rs;
    __device__ __forceinline__ void operator()(const f32x4 (&acc)[2][2][4][2], const Unit& u, int wr, int wc, int fr, int fq) const {
        const int row0 = u.pm * BM + wr * 64 + fr; const int col0 = u.pn * HALF + wc * 32 + 8 * fq; const RsView rv = rs_view(ldsx, u.pm);
#pragma unroll
        for (int ai = 0; ai < 2; ++ai)
#pragma unroll
            for (int m = 0; m < 4; ++m) { bf16_t* rowp = O + (size_t)(row0 + ai * HALF + m * 16) * ldc + col0; const float sc = RS_GET(rv, rs, row0 + ai * HALF + m * 16);
                float o[8];
#pragma unroll
                for (int n = 0; n < 2; ++n)
#pragma unroll
                    for (int e = 0; e < 4; ++e) { const float gv = acc[ai][0][m][n][e] * sc, uv = acc[ai][1][m][n][e] * sc; o[n * 4 + e] = fast_silu(gv) * uv; }
                u32x4 w; w.x = cvt_pk_bf16(o[0], o[1]); w.y = cvt_pk_bf16(o[2], o[3]); w.z = cvt_pk_bf16(o[4], o[5]); w.w = cvt_pk_bf16(o[6], o[7]);
                *(u32x4*)rowp = w; }
    }
};
struct EpiRes {
    static constexpr bool PERM = false, AFTER_DRAIN = false;
    const float* basef; float* outf; int ldc; bf16_t* xb; float* rsout;
    __device__ __forceinline__ void operator()(const f32x4 (&acc)[2][2][4][2], const Unit& u, int wr, int wc, int fr, int fq) const {
        const int row0 = u.pm * BM + wr * 64 + fr; const int col0 = u.pn * BM + wc * 32 + 4 * fq;
#pragma unroll
        for (int ai = 0; ai < 2; ++ai)
#pragma unroll
            for (int m = 0; m < 4; ++m) { const int row = row0 + ai * HALF + m * 16; const size_t off = (size_t)row * ldc + col0; float ss = 0.f;
#pragma unroll
                for (int bj = 0; bj < 2; ++bj)
#pragma unroll
                    for (int n = 0; n < 2; ++n) { const size_t o = off + bj * HALF + n * 16; f32x4 bs;
                        if (basef) bs = *(const f32x4*)(basef + o);
                        else { const u32x2v w = *(const u32x2v*)(xb + o); bs = (f32x4){__builtin_bit_cast(float, w.x << 16), __builtin_bit_cast(float, w.x & 0xffff0000u), __builtin_bit_cast(float, w.y << 16), __builtin_bit_cast(float, w.y & 0xffff0000u)}; }
                        const f32x4 v = bs + acc[ai][bj][m][n];
                        if (outf) *(f32x4*)(outf + o) = v;
                        ss += (v[0] * v[0] + v[1] * v[1]) + (v[2] * v[2] + v[3] * v[3]);
                        u32x2v w2; w2.x = cvt_pk_bf16(v[0], v[1]); w2.y = cvt_pk_bf16(v[2], v[3]); *(u32x2v*)(xb + o) = w2; }
                ss += __shfl_xor(ss, 16); ss += __shfl_xor(ss, 32);
                if (fq == 0) rsout[(size_t)row * 16 + u.pn * 4 + wc] = ss; }
    }
};
template <class Epi, class Sched, bool ALIGN_EPI = false, bool SP2 = false>
__device__ __forceinline__ void gemm_phase(PG8_LAS unsigned char* lds, const Gemm g, const Sched& S, const Epi& E, const int tid) {
    const int wid = __builtin_amdgcn_readfirstlane(tid >> 6), lane = tid & 63, wr = wid >> 2, wc = wid & 3, fr = lane & 15, fq = lane >> 4;
    const int K = g.K, nt = K / BK;
    unsigned voffA[2], voffB[2];
#pragma unroll
    for (int i = 0; i < 2; ++i) { int R, C; stage_rc(tid * 16 + i * 8192, R, C); const int Rb = Epi::PERM ? ((R & ~31) + perm32(R & 31)) : R;
        voffA[i] = (unsigned)(R * g.lda + C) * 2u; voffB[i] = (unsigned)(Rb * K + C) * 2u; }
    const size_t kstep = (size_t)(BK * 2);
    const size_t hstepA = (size_t)HALF * g.lda * 2, hstepB = (size_t)HALF * K * 2;
    const size_t tstepA = 2 * hstepA, tstepB = 2 * hstepB;
    const unsigned ldsw = (unsigned)wid * 1024u;
    const int aoff = lds_byte(wr * 64 + fr, fq * 8), boff = lds_byte(wc * 32 + fr, fq * 8);
#define PG8_SA(b, h) (((b) * 2 + (h)) * HTB)
#define PG8_SB(b, h) ((4 + (b) * 2 + (h)) * HTB)
#define PG8_STAGE(bufoff, gbase, voff) do { _Pragma("unroll") for (int _i = 0; _i < 2; ++_i) \
        __builtin_amdgcn_global_load_lds((const unsigned*)((const char*)(gbase) + (voff)[_i]), (PG8_LAS unsigned*)(lds + (bufoff) + ldsw + _i * 8192), 16, 0, 0); } while (0)
#define PG8_LDA(dst, b, h) do { _Pragma("unroll") for (int m = 0; m < 4; ++m) _Pragma("unroll") for (int k = 0; k < 2; ++k) dst[m][k] = *(const PG8_LAS bf16x8*)(lds + PG8_SA(b, h) + aoff + m * 2048 + k * 1024); } while (0)
#define PG8_LDB(dst, b, h) do { _Pragma("unroll") for (int n = 0; n < 2; ++n) _Pragma("unroll") for (int k = 0; k < 2; ++k) dst[n][k] = *(const PG8_LAS bf16x8*)(lds + PG8_SB(b, h) + boff + n * 2048 + k * 1024); } while (0)
#define PG8_MMA(ai, bj, At, Bt) do { __builtin_amdgcn_s_setprio(1); _Pragma("unroll") for (int m = 0; m < 4; ++m) _Pragma("unroll") for (int n = 0; n < 2; ++n) _Pragma("unroll") for (int k = 0; k < 2; ++k) \
        acc[ai][bj][m][n] = __builtin_amdgcn_mfma_f32_16x16x32_bf16(Bt[n][k], At[m][k], acc[ai][bj][m][n], 0, 0, 0); __builtin_amdgcn_s_setprio(0); } while (0)
#define PG8_WAIT_V(n) asm volatile("s_waitcnt vmcnt(" #n ")" ::: "memory")
#define PG8_WAIT_L(n) asm volatile("s_waitcnt lgkmcnt(" #n ")" ::: "memory")
#define PG8_BAR __builtin_amdgcn_s_barrier()
#define PG8_SCHED __builtin_amdgcn_sched_barrier(0)
    Unit cur, nxt; int ui = 0;
    if (!S.next(0, cur)) return;
    f32x4 acc[2][2][4][2];
#pragma unroll
    for (int a = 0; a < 2; ++a)
#pragma unroll
        for (int b = 0; b < 2; ++b)
#pragma unroll
            for (int m = 0; m < 4; ++m)
#pragma unroll
                for (int n = 0; n < 2; ++n) acc[a][b][m][n] = (f32x4){0.f, 0.f, 0.f, 0.f};
    bf16x8 At[4][2], B0[2][2], B1[2][2];
    const char* cA = (const char*)g.A + (size_t)cur.pm * tstepA; const char* cB = (const char*)g.Bt + (size_t)cur.pn * tstepB;
    S.a_ready(cur);
    if constexpr (SP2) {
        PG8_STAGE(PG8_SB(0, 0), cB, voffB); PG8_STAGE(PG8_SB(0, 1), cB + hstepB, voffB); PG8_STAGE(PG8_SA(0, 0), cA, voffA); PG8_STAGE(PG8_SA(0, 1), cA + hstepA, voffA);
        if (wr == 1) PG8_BAR;
        PG8_WAIT_V(2); PG8_BAR;
        PG8_STAGE(PG8_SB(1, 0), cB + kstep, voffB); PG8_STAGE(PG8_SA(1, 0), cA + kstep, voffA); PG8_STAGE(PG8_SB(1, 1), cB + hstepB + kstep, voffB);
        PG8_WAIT_V(6); PG8_BAR;
    } else {
        PG8_STAGE(PG8_SB(0, 0), cB, voffB); PG8_STAGE(PG8_SA(0, 0), cA, voffA); PG8_STAGE(PG8_SB(0, 1), cB + hstepB, voffB); PG8_STAGE(PG8_SA(0, 1), cA + hstepA, voffA);
        if (wr == 1) PG8_BAR;
        PG8_WAIT_V(4); PG8_BAR;
        PG8_STAGE(PG8_SB(1, 0), cB + kstep, voffB); PG8_STAGE(PG8_SA(1, 0), cA + kstep, voffA); PG8_STAGE(PG8_SB(1, 1), cB + hstepB + kstep, voffB);
        PG8_WAIT_V(6); PG8_BAR;
    }
    for (;;) {
        const bool has_next = S.next(ui + 1, nxt);
        const char* nA = has_next ? (const char*)g.A + (size_t)nxt.pm * tstepA : cA; const char* nB = has_next ? (const char*)g.Bt + (size_t)nxt.pn * tstepB : cB;
        for (int t = 0; t < nt; t += 2) {
            const bool last = (t == nt - 2);
            const char* a1 = cA + (size_t)(t + 1) * kstep;
            const char* a2 = last ? nA : cA + (size_t)(t + 2) * kstep; const char* b2 = last ? nB : cB + (size_t)(t + 2) * kstep;
            const char* a3 = a2 + kstep; const char* b3 = b2 + kstep;
            if (last && has_next) S.a_ready(nxt);
            if constexpr (SP2) {
            PG8_LDB(B0, 0, 0); PG8_LDB(B1, 0, 1); PG8_SCHED; PG8_LDA(At, 0, 0); PG8_STAGE(PG8_SA(1, 1), a1 + hstepA, voffA);
            PG8_WAIT_V(8); PG8_WAIT_L(0); PG8_BAR; PG8_MMA(0, 0, At, B0); PG8_MMA(0, 1, At, B1); PG8_BAR; PG8_SCHED;
            PG8_LDA(At, 0, 1); PG8_STAGE(PG8_SB(0, 0), b2, voffB); PG8_STAGE(PG8_SB(0, 1), b2 + hstepB, voffB); PG8_STAGE(PG8_SA(0, 0), a2, voffA);
            PG8_WAIT_V(8); PG8_WAIT_L(0); PG8_BAR; PG8_MMA(1, 0, At, B0); PG8_MMA(1, 1, At, B1); PG8_BAR; PG8_SCHED;
            PG8_LDB(B0, 1, 0); PG8_LDB(B1, 1, 1); PG8_SCHED; PG8_LDA(At, 1, 0); PG8_STAGE(PG8_SA(0, 1), a2 + hstepA, voffA);
            PG8_WAIT_V(8); PG8_WAIT_L(0); PG8_BAR; PG8_MMA(0, 0, At, B0); PG8_MMA(0, 1, At, B1); PG8_BAR; PG8_SCHED;
            PG8_LDA(At, 1, 1); PG8_STAGE(PG8_SB(1, 0), b3, voffB); PG8_STAGE(PG8_SB(1, 1), b3 + hstepB, voffB); PG8_STAGE(PG8_SA(1, 0), a3, voffA);
            PG8_WAIT_V(8); PG8_WAIT_L(0); PG8_BAR; PG8_MMA(1, 0, At, B0); PG8_MMA(1, 1, At, B1); PG8_BAR; PG8_SCHED;
            } else {
            PG8_LDB(B0, 0, 0); PG8_SCHED; PG8_LDA(At, 0, 0); PG8_STAGE(PG8_SA(1, 1), a1 + hstepA, voffA);
            PG8_WAIT_L(8); PG8_BAR; PG8_WAIT_L(0); PG8_MMA(0, 0, At, B0); PG8_BAR; PG8_SCHED;
            PG8_LDB(B1, 0, 1); PG8_STAGE(PG8_SB(0, 0), b2, voffB);
            PG8_BAR; PG8_WAIT_L(0); PG8_MMA(0, 1, At, B1); PG8_BAR;
            PG8_LDA(At, 0, 1); PG8_STAGE(PG8_SA(0, 0), a2, voffA);
            PG8_BAR; PG8_WAIT_L(0); PG8_MMA(1, 0, At, B0); PG8_BAR; PG8_SCHED;
            PG8_STAGE(PG8_SB(0, 1), b2 + hstepB, voffB);
            PG8_WAIT_V(6); PG8_BAR; PG8_MMA(1, 1, At, B1); PG8_BAR;
            PG8_LDB(B0, 1, 0); PG8_SCHED; PG8_LDA(At, 1, 0); PG8_STAGE(PG8_SA(0, 1), a2 + hstepA, voffA);
            PG8_WAIT_L(8); PG8_BAR; PG8_WAIT_L(0); PG8_MMA(0, 0, At, B0); PG8_BAR; PG8_SCHED;
            PG8_LDB(B1, 1, 1); PG8_STAGE(PG8_SB(1, 0), b3, voffB);
            PG8_BAR; PG8_WAIT_L(0); PG8_MMA(0, 1, At, B1); PG8_BAR;
            PG8_LDA(At, 1, 1); PG8_STAGE(PG8_SA(1, 0), a3, voffA);
            PG8_BAR; PG8_WAIT_L(0); PG8_MMA(1, 0, At, B0); PG8_BAR; PG8_SCHED;
            PG8_STAGE(PG8_SB(1, 1), b3 + hstepB, voffB);
            PG8_WAIT_V(6); PG8_BAR; PG8_MMA(1, 1, At, B1); PG8_BAR;
            }
        }
        if constexpr (ALIGN_EPI) { if (wr == 0) PG8_BAR; }
        if constexpr (!Epi::AFTER_DRAIN) { E(acc, cur, wr, wc, fr, fq); S.done(cur); }
        if (!has_next) break;
#pragma unroll
        for (int a = 0; a < 2; ++a)
#pragma unroll
            for (int b = 0; b < 2; ++b)
#pragma unroll
                for (int m = 0; m < 4; ++m)
#pragma unroll
                    for (int n = 0; n < 2; ++n) acc[a][b][m][n] = (f32x4){0.f, 0.f, 0.f, 0.f};
        cur = nxt; cA = nA; cB = nB; ++ui;
        if constexpr (ALIGN_EPI) { if (wr == 1) PG8_BAR; }
    }
    PG8_WAIT_V(0);
    if constexpr (!ALIGN_EPI) { if (wr == 0) PG8_BAR; }
    PG8_BAR;
    if constexpr (Epi::AFTER_DRAIN) { E.fused(acc, cur, wr, wc, fr, fq, lds, wid, lane); S.done(cur); }
#undef PG8_SA
#undef PG8_SB
#undef PG8_STAGE
#undef PG8_LDA
#undef PG8_LDB
#undef PG8_MMA
#undef PG8_WAIT_V
#undef PG8_WAIT_L
#undef PG8_BAR
#undef PG8_SCHED
}
}
#define LAS __attribute__((address_space(3)))
typedef unsigned short bf16;
typedef short bf16x8 __attribute__((ext_vector_type(8)));
typedef float f32x4 __attribute__((ext_vector_type(4)));
typedef unsigned u32x4 __attribute__((ext_vector_type(4)));
typedef unsigned u32x2 __attribute__((ext_vector_type(2)));
constexpr int BATCH = 8, SEQ = 4096, DM = 1024, M = BATCH * SEQ, DEPTH = 4;
constexpr int REC_IN = 4624, PROJ_LD = 4864, REC_OUT = 2048, QKV_LD = 3072, FFN_H = 2816, GU_N = 5632;
constexpr int C_LRUX = 0, C_GATE = 1024, C_Z = 2048, C_XS = 3072, C_B = 4096, C_C = 4352;
constexpr float EPS = 1e-6f;
constexpr int NWAVES = 8, NTHREADS = 512;
constexpr int LDS_BYTES = 147456;
constexpr size_t MiB = 1u << 20;
constexpr size_t W_REC_IN = 0, W_REC_OUT = 19922944, W_QKV = 28311552, W_ATT_OUT = 40894464, W_GU = 45088768, W_DOWN = 91226112, W_LRU = 114294784, W_DTW = 114819072, W_END = 114819072 + 65536;
constexpr size_t SZ_REC_IN = 9961472, SZ_REC_OUT = 4194304, SZ_QKV = 6291456, SZ_ATT_OUT = 2097152, SZ_GU = 11534336, SZ_DOWN = 5767168, SZ_LRU = 131072;
constexpr size_t WS_H = 110 * MiB, WS_PROJ = 174 * MiB, WS_DT = 478 * MiB, WS_HALO = 481 * MiB, WS_RS = 489 * MiB, WS_CTL = 491 * MiB, WS_SSQ = 492 * MiB, WS_END = 500 * MiB;
static_assert(W_END <= WS_H && WS_H + (size_t)M * DM * 2 <= WS_PROJ && WS_PROJ + (size_t)M * PROJ_LD * 2 <= WS_DT && WS_HALO + (size_t)BATCH * 64 * 3 * 2560 * 2 <= WS_END, "ws map");

__device__ __forceinline__ unsigned f2bf(float f) { unsigned u = __builtin_bit_cast(unsigned, f); return (u + 0x7fffu + ((u >> 16) & 1u)) >> 16; }
__device__ __forceinline__ float bf2f(unsigned h) { return __builtin_bit_cast(float, h << 16); }
__device__ __forceinline__ unsigned pk2(float lo, float hi) { typedef float f32x2_t __attribute__((ext_vector_type(2))); typedef __bf16 bf16x2_t __attribute__((ext_vector_type(2))); const f32x2_t v = {lo, hi}; const bf16x2_t bb = __builtin_convertvector(v, bf16x2_t); return __builtin_bit_cast(unsigned, bb); }
__device__ __forceinline__ float bflo(unsigned w) { return __builtin_bit_cast(float, w << 16); }
__device__ __forceinline__ float bfhi(unsigned w) { return __builtin_bit_cast(float, w & 0xffff0000u); }
__device__ __forceinline__ void unpack8(const u32x4 v, float* x) { x[0] = bflo(v.x); x[1] = bfhi(v.x); x[2] = bflo(v.y); x[3] = bfhi(v.y); x[4] = bflo(v.z); x[5] = bfhi(v.z); x[6] = bflo(v.w); x[7] = bfhi(v.w); }
__device__ __forceinline__ u32x4 pack8(const float* x) { u32x4 v; v.x = pk2(x[0], x[1]); v.y = pk2(x[2], x[3]); v.z = pk2(x[4], x[5]); v.w = pk2(x[6], x[7]); return v; }
#define LDS_FENCE() asm volatile("s_waitcnt lgkmcnt(0)" ::: "memory")
__device__ __forceinline__ float wave_sum(float v) {
#pragma unroll
    for (int o = 1; o < 64; o <<= 1) v += __shfl_xor(v, o);
    return v;
}
__device__ __forceinline__ float softplus_f(float x) { return x > 20.f ? x : log1pf(__expf(x)); }
__device__ __forceinline__ float gelu_tanh(float x) { const float y = 0.7978845608028654f * (x + 0.044715f * x * x * x); const float e = pg8::fast_exp(2.f * y); const float t = 1.f - 2.f * __builtin_amdgcn_rcpf(e + 1.f); return 0.5f * x * (1.f + t); }

struct Ctx {
    LAS unsigned char* lds; int tid, lane, wave, G, bid;
    float* out; unsigned char* ws;
};

__device__ __forceinline__ void transpose_item(const float* W, int K, int ldw, int ncv, int src_col0, bf16* WT, int dst_row0, LAS float* scr, int k0, int lane, const float* gain, const bool swap48 = false) {
    { const int c4 = (lane & 7) * 4, c4s = (swap48 && (c4 == 4 || c4 == 8)) ? 12 - c4 : c4, col = src_col0 + c4s; const bool ok = col < ncv;
      f32x4 v[8];
#pragma unroll
      for (int i = 0; i < 8; ++i) { const int kk = 8 * i + (lane >> 3); v[i] = ok ? *(const f32x4*)(W + (size_t)(k0 + kk) * ldw + col) : (f32x4){0.f, 0.f, 0.f, 0.f}; }
#pragma unroll
      for (int i = 0; i < 8; ++i) { const int kk = 8 * i + (lane >> 3); const float gk = gain ? gain[k0 + kk] : 1.0f;
          scr[kk * 33 + c4] = v[i][0] * gk; scr[kk * 33 + c4 + 1] = v[i][1] * gk; scr[kk * 33 + c4 + 2] = v[i][2] * gk; scr[kk * 33 + c4 + 3] = v[i][3] * gk; } }
    LDS_FENCE();
    const int c = lane & 7;
#pragma unroll
    for (int jj = 0; jj < 4; ++jj) { const int n = (lane >> 3) + 8 * jj; const LAS float* s = scr + (8 * c) * 33 + n;
        u32x4 o; o.x = pk2(s[0 * 33], s[1 * 33]); o.y = pk2(s[2 * 33], s[3 * 33]); o.z = pk2(s[4 * 33], s[5 * 33]); o.w = pk2(s[6 * 33], s[7 * 33]);
        *(u32x4*)(WT + (size_t)(dst_row0 + n) * K + k0 + 8 * c) = o; }
    LDS_FENCE();
}
__device__ __forceinline__ void p0_weights(Ctx& F, const float* w_rec_in, const float* w_rec_out, const float* w_qkv, const float* w_att_out, const float* w_gu, const float* w_down, const float* w_lr, const float* w_li, const float* g_rec, const float* g_att, const float* g_ffn, const float* x_in) {
    LAS float* scr = (LAS float*)(F.lds + F.wave * 8448);
    const int gw = F.bid * NWAVES + F.wave, NGW = F.G * NWAVES; const int gt0_ = F.bid * NTHREADS + F.tid, NT0_ = F.G * NTHREADS;
    constexpr int TOTAL = 4608 + 2048 + 3072 + 1024 + 11264 + 5632;
    for (int it = gw; it < TOTAL; it += NGW) {
        int r = it; const float* W; const float* gain = nullptr; int K, ldw, ncv, nbn, kind = 0; bf16* WT;
        if (r < 4608) { const int i = r / 2304; r %= 2304; W = w_rec_in + (size_t)i * 1024 * REC_IN; gain = g_rec + i * DM; K = 1024; ldw = REC_IN; ncv = REC_IN; nbn = 144; WT = (bf16*)(F.ws + W_REC_IN + i * SZ_REC_IN); }
        else { r -= 4608;
        if (r < 2048) { const int i = r / 1024; r %= 1024; W = w_rec_out + (size_t)i * 2048 * 1024; K = 2048; ldw = 1024; ncv = 1024; nbn = 32; WT = (bf16*)(F.ws + W_REC_OUT + i * SZ_REC_OUT); }
        else { r -= 2048;
        if (r < 3072) { const int i = r / 1536; r %= 1536; W = w_qkv + (size_t)i * 1024 * 3072; gain = g_att + i * DM; K = 1024; ldw = 3072; ncv = 3072; nbn = 96; kind = 2; WT = (bf16*)(F.ws + W_QKV + i * SZ_QKV); }
        else { r -= 3072;
        if (r < 1024) { const int i = r / 512; r %= 512; W = w_att_out + (size_t)i * 1024 * 1024; K = 1024; ldw = 1024; ncv = 1024; nbn = 32; WT = (bf16*)(F.ws + W_ATT_OUT + i * SZ_ATT_OUT); }
        else { r -= 1024;
        if (r < 11264) { const int l = r / 2816; r %= 2816; W = w_gu + (size_t)l * 1024 * GU_N; gain = g_ffn + l * DM; K = 1024; ldw = GU_N; ncv = GU_N; nbn = 176; kind = 1; WT = (bf16*)(F.ws + W_GU + l * SZ_GU); }
        else { r -= 11264; const int l = r / 1408; r %= 1408; W = w_down + (size_t)l * FFN_H * 1024; K = FFN_H; ldw = 1024; ncv = 1024; nbn = 32; WT = (bf16*)(F.ws + W_DOWN + l * SZ_DOWN); } } } } }
        const int kb = r / nbn, nb = r % nbn, n0 = 32 * nb; int src = n0;
        if (kind == 1) { const int tile = n0 >> 8, within = n0 & 255; src = within < 128 ? 128 * tile + within : FFN_H + 128 * tile + (within - 128); }
        bool swap48 = false;
        if (kind == 2 && n0 < 2048) { const int t = n0 >> 8, within = n0 & 255, bj = within >> 7, wc = (within >> 5) & 3; src = (t >> 2) * 1024 + (4 * (t & 3) + wc) * 64 + bj * 32; swap48 = (bj == 0); }
        transpose_item(W, K, ldw, ncv, src, WT, n0, scr, 64 * kb, F.lane, gain, swap48);
    }
    for (int m = gw; m < M; m += NGW) {
        const f32x4* xr = (const f32x4*)(x_in + (size_t)m * DM) + F.lane; f32x4 v[4]; float s = 0.f;
#pragma unroll
        for (int jj = 0; jj < 4; ++jj) { v[jj] = xr[64 * jj]; s += (v[jj].x * v[jj].x + v[jj].y * v[jj].y) + (v[jj].z * v[jj].z + v[jj].w * v[jj].w); }
        s = wave_sum(s);
        u32x2* o8 = (u32x2*)((bf16*)(F.ws + WS_H) + (size_t)m * DM) + F.lane;
#pragma unroll
        for (int jj = 0; jj < 4; ++jj) { u32x2 w; w.x = pk2(v[jj].x, v[jj].y); w.y = pk2(v[jj].z, v[jj].w); o8[64 * jj] = w; }
        if (F.lane < 16) ((float*)(F.ws + WS_RS))[(size_t)m * 16 + F.lane] = (F.lane == 0) ? s : 0.f;
    }
    for (int i = gt0_; i < BATCH * 3 * 320; i += NT0_) { const int bq = i / 960, rem = i % 960; *(u32x4*)((bf16*)(F.ws + WS_HALO) + (size_t)(bq * 192 + rem / 320) * 2560 + (rem % 320) * 8) = (u32x4){0u, 0u, 0u, 0u}; }
    for (int idx = gt0_; idx < 2 * 16 * 1024; idx += NT0_) { const int ly = idx >> 14, jc = (idx >> 10) & 15, k = idx & 1023;
        ((bf16*)(F.ws + W_DTW))[idx] = (bf16)f2bf(g_rec[ly * DM + k] * w_rec_in[(size_t)ly * 1024 * REC_IN + (size_t)k * REC_IN + 4608 + jc]); }
    const int gt = F.bid * NTHREADS + F.tid, NT = F.G * NTHREADS;
    for (int idx = gt; idx < 4 * 65536; idx += NT) { const int mat = idx >> 16, e = idx & 65535, h = e >> 12, jj = (e >> 6) & 63, ii = e & 63;
        const float* src = (mat & 1) ? w_li : w_lr; const int layer = mat >> 1;
        ((bf16*)(F.ws + W_LRU))[(size_t)mat * 65536 + e] = (bf16)f2bf(src[(size_t)layer * 65536 + h * 4096 + ii * 64 + jj]); }
}
__device__ __forceinline__ void norm_phase(Ctx& F, const float* x, const float* gain, bf16* out) {
    const int gw = F.bid * NWAVES + F.wave, NGW = F.G * NWAVES;
    f32x4 gv[4];
#pragma unroll
    for (int jj = 0; jj < 4; ++jj) gv[jj] = ((const f32x4*)gain)[F.lane + 64 * jj];
    for (int m = gw; m < M; m += NGW) {
        const f32x4* xr = (const f32x4*)(x + (size_t)m * DM) + F.lane; f32x4 v[4]; float s = 0.f;
#pragma unroll
        for (int jj = 0; jj < 4; ++jj) { v[jj] = xr[64 * jj]; s += (v[jj].x * v[jj].x + v[jj].y * v[jj].y) + (v[jj].z * v[jj].z + v[jj].w * v[jj].w); }
        const float rs = 1.0f / sqrtf(wave_sum(s) * (1.f / DM) + EPS);
        u32x2* o8 = (u32x2*)(out + (size_t)m * DM) + F.lane;
#pragma unroll
        for (int jj = 0; jj < 4; ++jj) { u32x2 w; w.x = pk2(v[jj].x * rs * gv[jj].x, v[jj].y * rs * gv[jj].y); w.y = pk2(v[jj].z * rs * gv[jj].z, v[jj].w * rs * gv[jj].w); o8[64 * jj] = w; }
    }
}
__device__ __forceinline__ void halo_phase(Ctx& F) {
    const bf16* proj = (const bf16*)(F.ws + WS_PROJ); bf16* halo = (bf16*)(F.ws + WS_HALO);
    const int gw = F.bid * NWAVES + F.wave, NGW = F.G * NWAVES;
    for (int hr = gw; hr < BATCH * 64 * 3; hr += NGW) {
        const int b = hr / 192, rem = hr % 192, c = rem / 3, jj = rem % 3, t = c * 64 - 3 + jj;
#pragma unroll
        for (int q = 0; q < 5; ++q) { const int gidx = F.lane + 64 * q; const int col = gidx < 128 ? gidx * 8 : C_XS + (gidx - 128) * 8;
            u32x4 v; if (t >= 0) v = *(const u32x4*)(proj + (size_t)(b * SEQ + t) * PROJ_LD + col); else { unsigned z_; asm volatile("v_mov_b32 %0, 0" : "=v"(z_)); v = (u32x4){z_, z_, z_, z_}; }
            *(u32x4*)(halo + (size_t)hr * 2560 + gidx * 8) = v; }
    }
}
__device__ __forceinline__ void conv_phase(Ctx& F, int li, const float* lcw, const float* lcb, const float* scw, const float* scb) {
    bf16* proj = (bf16*)(F.ws + WS_PROJ); const bf16* halo = (const bf16*)(F.ws + WS_HALO);
    if (F.tid >= 320) {
        const int lane = F.lane, j = lane & 15, g = lane >> 4, wv = F.wave - 5;
        const bf16* xb = (const bf16*)(F.ws + WS_H); const bf16* wdt = (const bf16*)(F.ws + W_DTW) + (size_t)li * 16 * 1024 + (size_t)j * 1024 + 8 * g;
        float* dtb_ = (float*)(F.ws + WS_DT); const float* rs = (const float*)(F.ws + WS_RS);
        for (int it = F.bid; it < BATCH * 64; it += F.G) {
            const int t_lo = wv == 0 ? 0 : wv + 1, t_hi = wv == 0 ? 2 : wv + 2;
            for (int tl = t_lo; tl < t_hi; ++tl) { const int R0 = it * 64 + 16 * tl;
                const bf16* ap = xb + (size_t)(R0 + j) * DM + 8 * g; f32x4 acc = (f32x4){0.f, 0.f, 0.f, 0.f};
#pragma unroll 8
                for (int ks = 0; ks < 32; ++ks) acc = __builtin_amdgcn_mfma_f32_16x16x32_bf16(*(const bf16x8*)(ap + 32 * ks), *(const bf16x8*)(wdt + 32 * ks), acc, 0, 0, 0);
#pragma unroll
                for (int r = 0; r < 4; ++r) { const int row = R0 + 4 * g + r; dtb_[(size_t)row * 16 + j] = acc[r] * pg8::row_rs(rs, row); } } }
        return; }
    const int gidx = F.tid; const bool ssd = gidx >= 128; const int col = ssd ? C_XS + (gidx - 128) * 8 : gidx * 8;
    const float* cw = ssd ? scw + (size_t)li * 4 * 1536 + (gidx - 128) * 8 : lcw + (size_t)li * 4 * 1024 + gidx * 8;
    const float* cb = ssd ? scb + (size_t)li * 1536 + (gidx - 128) * 8 : lcb + (size_t)li * 1024 + gidx * 8;
    const int cstride = ssd ? 1536 : 1024;
    float w[4][8], bias[8];
#pragma unroll
    for (int jj = 0; jj < 4; ++jj)
#pragma unroll
        for (int e = 0; e < 8; ++e) w[jj][e] = cw[jj * cstride + e];
#pragma unroll
    for (int e = 0; e < 8; ++e) bias[e] = cb[e];
    for (int it = F.bid; it < BATCH * 64; it += F.G) {
        const int b = it >> 6, c = it & 63;
        float p3[8], p2[8], p1[8];
        { const bf16* hp = halo + (size_t)(it * 3) * 2560 + gidx * 8;
          unpack8(*(const u32x4*)hp, p3); unpack8(*(const u32x4*)(hp + 2560), p2); unpack8(*(const u32x4*)(hp + 5120), p1); }
        bf16* pp = proj + (size_t)(b * SEQ + c * 64) * PROJ_LD + col;
#pragma unroll 16
        for (int t = 0; t < 64; ++t) {
            float cur[8], y[8]; unpack8(*(const u32x4*)(pp + (size_t)t * PROJ_LD), cur);
#pragma unroll
            for (int e = 0; e < 8; ++e) { float v = bias[e] + w[0][e] * p3[e] + w[1][e] * p2[e] + w[2][e] * p1[e] + w[3][e] * cur[e]; if (ssd) v = pg8::fast_silu(v); y[e] = v; p3[e] = p2[e]; p2[e] = p1[e]; p1[e] = cur[e]; }
            *(u32x4*)(pp + (size_t)t * PROJ_LD) = pack8(y);
        }
    }
}
#define MFMA16(a, b, c) __builtin_amdgcn_mfma_f32_16x16x32_bf16((a), (b), (c), 0, 0, 0)
__device__ __forceinline__ void lru_item(Ctx& F, int li, int b, int blk, const float* p_br, const float* p_bi, const float* p_lam, const bool wr = true) {
    LAS float* sa = (LAS float*)F.lds;
    LAS float* su = sa + 128 * 68;
    LAS float* segA = su + 128 * 68;
    LAS float* segH = segA + 512;
    const int lane = F.lane, wave = F.wave, j = lane & 15, g = lane >> 4;
    LAS bf16* xs = (LAS bf16*)(segH + 512) + wave * (16 * 72);
    LAS bf16* gs = (LAS bf16*)(segH + 512) + 8 * (16 * 72) + wave * (16 * 72);
    const bf16* WrT = (const bf16*)(F.ws + W_LRU) + (size_t)(2 * li) * 65536 + blk * 4096;
    const bf16* WiT = (const bf16*)(F.ws + W_LRU) + (size_t)(2 * li + 1) * 65536 + blk * 4096;
    bf16x8 br[4][2], bi[4][2]; float biasr[4], biasi[4], c8sp[4];
#pragma unroll
    for (int nt = 0; nt < 4; ++nt) {
#pragma unroll
        for (int ks = 0; ks < 2; ++ks) { br[nt][ks] = *(const bf16x8*)(WrT + (16 * nt + j) * 64 + 32 * ks + 8 * g); bi[nt][ks] = *(const bf16x8*)(WiT + (16 * nt + j) * 64 + 32 * ks + 8 * g); }
        const int c = li * 1024 + blk * 64 + 16 * nt + j; biasr[nt] = p_br[c]; biasi[nt] = p_bi[c]; c8sp[nt] = 8.0f * log1pf(__expf(-p_lam[c])); }
    float hprev = 0.f;
    bf16* xbase = (bf16*)(F.ws + WS_PROJ) + (size_t)b * SEQ * PROJ_LD + blk * 64;
    const bf16* ap = xbase + (size_t)(16 * wave + j) * PROJ_LD + 8 * g;
    bf16* gpt = xbase + C_GATE + (size_t)(16 * wave + (lane >> 2)) * PROJ_LD + 16 * (lane & 3);
    bf16x8 na0 = *(const bf16x8*)ap, na1 = *(const bf16x8*)(ap + 32);
    u32x4 ng0 = *(const u32x4*)gpt, ng1 = *(const u32x4*)(gpt + 8);
    for (int ch = 0; ch < 32; ++ch) {
        const bf16x8 a0 = na0, a1 = na1; const u32x4 g0 = ng0, g1 = ng1;
        if (ch + 1 < 32) { const size_t o = (size_t)(ch + 1) * 128 * PROJ_LD; na0 = *(const bf16x8*)(ap + o); na1 = *(const bf16x8*)(ap + o + 32); ng0 = *(const u32x4*)(gpt + o); ng1 = *(const u32x4*)(gpt + o + 8); }
        *(LAS bf16x8*)(xs + j * 72 + 8 * g) = a0; *(LAS bf16x8*)(xs + j * 72 + 32 + 8 * g) = a1;
        *(LAS u32x4*)(gs + (lane >> 2) * 72 + 16 * (lane & 3)) = g0; *(LAS u32x4*)(gs + (lane >> 2) * 72 + 16 * (lane & 3) + 8) = g1;
        LDS_FENCE();
#pragma unroll
        for (int nt = 0; nt < 4; ++nt) {
            f32x4 dr = (f32x4){0.f, 0.f, 0.f, 0.f}, di = (f32x4){0.f, 0.f, 0.f, 0.f};
            dr = MFMA16(a0, br[nt][0], dr); dr = MFMA16(a1, br[nt][1], dr);
            di = MFMA16(a0, bi[nt][0], di); di = MFMA16(a1, bi[nt][1], di);
#pragma unroll
            for (int r = 0; r < 4; ++r) { const int tl = 16 * wave + 4 * g + r, c = 16 * nt + j;
                const float xc = bf2f(xs[(4 * g + r) * 72 + c]);
                const float rg = pg8::fast_sigmoid(dr[r] + biasr[nt]), ig = pg8::fast_sigmoid(di[r] + biasi[nt]);
                const float la = -rg * c8sp[nt]; const float a = pg8::fast_exp(la); const float u = __builtin_amdgcn_sqrtf(fmaxf(1.0f - a * a, 0.f)) * ig * xc;
                sa[tl * 68 + c] = a; su[tl * 68 + c] = u; } }
        __syncthreads();
        { float A = 1.f, H = 0.f;
#pragma unroll
          for (int k = 0; k < 16; ++k) { const int idx = (16 * wave + k) * 68 + lane; const float a = sa[idx], u = su[idx]; H = a * H + u; A = A * a; su[idx] = H; sa[idx] = A; }
          segA[wave * 64 + lane] = A; segH[wave * 64 + lane] = H; }
        __syncthreads();
        float carry = hprev, hp = hprev;
#pragma unroll
        for (int w2 = 0; w2 < 8; ++w2) { const float A = segA[w2 * 64 + lane], H = segH[w2 * 64 + lane]; if (w2 == wave) carry = hp; hp = A * hp + H; }
        hprev = hp;
#pragma unroll 4
        for (int k = 0; k < 16; ++k) { const int idx = (16 * wave + k) * 68 + lane; const float h = su[idx] + sa[idx] * carry;
            const float gate = bf2f(gs[k * 72 + lane]); gs[k * 72 + lane] = (bf16)f2bf(h * gate); }
        LDS_FENCE();
        if (wr) { bf16* op = gpt + (size_t)ch * 128 * PROJ_LD; *(u32x4*)op = *(const LAS u32x4*)(gs + (lane >> 2) * 72 + 16 * (lane & 3)); *(u32x4*)(op + 8) = *(const LAS u32x4*)(gs + (lane >> 2) * 72 + 16 * (lane & 3) + 8); }
        __syncthreads();
    }
}
template <int K>
__device__ __forceinline__ f32x4 mma_lds(f32x4 acc, const LAS bf16* A, int pitchA, int rowA0, const LAS bf16* Bt, int pitchB, int rowB0, int j, int g) {
#pragma unroll
    for (int ks = 0; ks < K / 32; ++ks) { const bf16x8 a = *(const LAS bf16x8*)(A + (rowA0 + j) * pitchA + 32 * ks + 8 * g); const bf16x8 bb = *(const LAS bf16x8*)(Bt + (rowB0 + j) * pitchB + 32 * ks + 8 * g); acc = MFMA16(a, bb, acc); }
    return acc;
}
__device__ __forceinline__ void ssd_item(Ctx& F, int li, int b, int head, const float* p_dtb, const float* p_alog, const float* p_d, const bool wr = true) {
    LAS bf16* Cs = (LAS bf16*)F.lds;
    LAS bf16* Bs = Cs + 64 * 136;
    LAS bf16* BT = Bs + 64 * 136;
    LAS bf16* XT = BT + 128 * 72;
    LAS bf16* XwT = XT + 64 * 72;
    LAS bf16* Ms = XwT + 64 * 72;
    LAS bf16* Ss = Ms + 64 * 72;
    LAS float* csv = (LAS float*)(Ss + 64 * 136);
    LAS float* dtv = csv + 64;
    LAS float* wv = dtv + 64;
    LAS bf16* Zs = (LAS bf16*)(wv + 64);
    const int tid = F.tid, lane = F.lane, wave = F.wave, j = lane & 15, g = lane >> 4, grp = head >> 3;
    const float a_h = -__expf(p_alog[li * 16 + head]), dtb = p_dtb[li * 16 + head], Dh = p_d[li * 16 + head];
    bf16* proj = (bf16*)(F.ws + WS_PROJ) + (size_t)b * SEQ * PROJ_LD;
    const bf16* pB = proj + C_B + 128 * grp; const bf16* pC = proj + C_C + 128 * grp; const bf16* pX = proj + C_XS + 64 * head; bf16* pZ = proj + C_Z + 64 * head;
    const float* dtp = (const float*)(F.ws + WS_DT) + (size_t)b * SEQ * 16 + head;
    float* ssq = (float*)(F.ws + WS_SSQ) + (size_t)b * SEQ * 32 + grp * 16 + (head & 7) * 2 + (wave & 1);
    f32x4 sacc[4];
#pragma unroll
    for (int pt = 0; pt < 4; ++pt) sacc[pt] = (f32x4){0.f, 0.f, 0.f, 0.f};
    for (int i = tid; i < 64 * 136 / 2; i += NTHREADS) ((LAS unsigned*)Ss)[i] = 0u;
    const int row = tid >> 3, cseg = (tid & 7) * 8;
    u32x4 rB0, rB1, rC0, rC1, rX, rZ; float rdt = 0.f;
    { const size_t o = (size_t)row * PROJ_LD + cseg; rB0 = *(const u32x4*)(pB + o); rB1 = *(const u32x4*)(pB + o + 64); rC0 = *(const u32x4*)(pC + o); rC1 = *(const u32x4*)(pC + o + 64); rX = *(const u32x4*)(pX + o); rZ = *(const u32x4*)(pZ + o);
      if (wave == 0) rdt = dtp[(size_t)lane * 16]; }
    for (int c = 0; c < 64; ++c) {
        const int tok0 = c * 64;
        if (c > 0 && wr) *(u32x4*)(pZ + (size_t)(tok0 - 64 + row) * PROJ_LD + cseg) = *(const LAS u32x4*)(Zs + row * 72 + cseg);
        *(LAS u32x4*)(Zs + row * 72 + cseg) = rZ;
        *(LAS u32x4*)(Cs + row * 136 + cseg) = rC0; *(LAS u32x4*)(Cs + row * 136 + cseg + 64) = rC1;
        *(LAS u32x4*)(Bs + row * 136 + cseg) = rB0; *(LAS u32x4*)(Bs + row * 136 + cseg + 64) = rB1;
        { const unsigned wds[8] = {rB0.x, rB0.y, rB0.z, rB0.w, rB1.x, rB1.y, rB1.z, rB1.w};
#pragma unroll
          for (int q = 0; q < 8; ++q) { const int n = cseg + (q >> 2) * 64 + (q & 3) * 2; BT[n * 72 + row] = (bf16)(wds[q] & 0xffffu); BT[(n + 1) * 72 + row] = (bf16)(wds[q] >> 16); } }
        if (wave == 0) {
            const float dt = softplus_f(rdt + dtb); float cs = dt * a_h;
#pragma unroll
            for (int off = 1; off < 64; off <<= 1) { const float v = __shfl_up(cs, off); if (lane >= off) cs += v; }
            const float tot = __shfl(cs, 63);
            csv[lane] = cs; dtv[lane] = dt; wv[lane] = dt * __expf(tot - cs);
        }
        __syncthreads();
        { float x[8]; unpack8(rX, x); const float wr_ = wv[row];
#pragma unroll
          for (int e = 0; e < 8; ++e) { XT[(cseg + e) * 72 + row] = (bf16)f2bf(x[e]); XwT[(cseg + e) * 72 + row] = (bf16)f2bf(x[e] * wr_); } }
        __syncthreads();
        if (c + 1 < 64) { const size_t o = (size_t)(tok0 + 64 + row) * PROJ_LD + cseg; rB0 = *(const u32x4*)(pB + o); rB1 = *(const u32x4*)(pB + o + 64); rC0 = *(const u32x4*)(pC + o); rC1 = *(const u32x4*)(pC + o + 64); rX = *(const u32x4*)(pX + o); rZ = *(const u32x4*)(pZ + o);
            if (wave == 0) rdt = dtp[(size_t)(tok0 + 64 + lane) * 16]; }
        const int lt = wave >> 1; f32x4 yacc[2];
#pragma unroll
        for (int q = 0; q < 2; ++q) { const int st = 2 * (wave & 1) + q;
            f32x4 G = mma_lds<128>((f32x4){0.f, 0.f, 0.f, 0.f}, Cs, 136, 16 * lt, Bs, 136, 16 * st, j, g);
            const int s = 16 * st + j; const float css = csv[s], dts = dtv[s];
#pragma unroll
            for (int r = 0; r < 4; ++r) { const int l = 16 * lt + 4 * g + r; const float dd = csv[l] - css; const float val = (s <= l) ? G[r] * __expf(fminf(dd, 0.f)) * dts : 0.f; Ms[l * 72 + s] = (bf16)f2bf(val); }
            f32x4 yo = mma_lds<128>((f32x4){0.f, 0.f, 0.f, 0.f}, Cs, 136, 16 * lt, Ss, 136, 16 * st, j, g);
#pragma unroll
            for (int r = 0; r < 4; ++r) yo[r] *= __expf(csv[16 * lt + 4 * g + r]);
            yacc[q] = yo; }
        __syncthreads();
        float sq[4] = {0.f, 0.f, 0.f, 0.f};
#pragma unroll
        for (int q = 0; q < 2; ++q) { const int pt = 2 * (wave & 1) + q; yacc[q] = mma_lds<64>(yacc[q], Ms, 72, 16 * lt, XT, 72, 16 * pt, j, g);
            const int p = 16 * pt + j;
#pragma unroll
            for (int r = 0; r < 4; ++r) { const int l = 16 * lt + 4 * g + r; const float x = bf2f(XT[p * 72 + l]); const float y = yacc[q][r] + Dh * x;
                const float z = bf2f(Zs[l * 72 + p]); const float v = y * pg8::fast_silu(z); Zs[l * 72 + p] = (bf16)f2bf(v); sq[r] += v * v; } }
#pragma unroll
        for (int r = 0; r < 4; ++r) { float s = sq[r]; s += __shfl_xor(s, 1); s += __shfl_xor(s, 2); s += __shfl_xor(s, 4); s += __shfl_xor(s, 8);
            if (j == 0 && wr) ssq[(size_t)(tok0 + 16 * lt + 4 * g + r) * 32] = s; }
        const float dec = __expf(csv[63]);
#pragma unroll
        for (int pt = 0; pt < 4; ++pt) { sacc[pt] = sacc[pt] * dec; sacc[pt] = mma_lds<64>(sacc[pt], XwT, 72, 16 * pt, BT, 72, 16 * wave, j, g);
#pragma unroll
            for (int r = 0; r < 4; ++r) Ss[(16 * pt + 4 * g + r) * 136 + 16 * wave + j] = (bf16)f2bf(sacc[pt][r]); }
        __syncthreads();
    }
    if (wr) *(u32x4*)(pZ + (size_t)(63 * 64 + row) * PROJ_LD + cseg) = *(const LAS u32x4*)(Zs + row * 72 + cseg);
}
typedef short v4i16_t __attribute__((ext_vector_type(4)));
__device__ __forceinline__ bf16x8 tr_frag(const LAS bf16* T, int pitch, int row0, int col0, int lane) {
    const LAS bf16* a = T + (row0 + 8 * (lane >> 4) + ((lane & 15) >> 2)) * pitch + col0 + 4 * (lane & 3);
    const v4i16_t t0 = __builtin_amdgcn_ds_read_tr16_b64_v4i16((LAS v4i16_t*)a);
    const v4i16_t t1 = __builtin_amdgcn_ds_read_tr16_b64_v4i16((LAS v4i16_t*)(a + 4 * pitch));
    return (bf16x8){t0[0], t0[1], t0[2], t0[3], t1[0], t1[1], t1[2], t1[3]};
}
constexpr size_t SSD_STATE_OFF = 0, SSD_DEC_OFF = 40 * MiB;
template <int PASS>
__device__ __forceinline__ void ssd_seg_item(Ctx& F, int li, int b, int hp, int seg, const float* p_dtb, const float* p_alog, const float* p_d) {
    LAS bf16* Bs = (LAS bf16*)F.lds;
    LAS bf16* Cs = Bs + 64 * 144;
    LAS bf16* Gs = Cs + 64 * 136;
    const int tid = F.tid, lane = F.lane, wave = F.wave, j = lane & 15, g = lane >> 4;
    LAS bf16* Xw_ = Gs + 2 * 64 * 72 + wave * (2 * 64 * 24);
    LAS bf16* Zw_ = Xw_ + 64 * 24;
    LAS float* csw = (LAS float*)(Gs + 2 * 64 * 72 + 8 * (2 * 64 * 24)) + (wave >> 2) * 192;
    LAS float* dtw = csw + 64; LAS float* ww = dtw + 64;
    const int head = 2 * hp + (wave >> 2), ph = wave & 3, grp = head >> 3;
    const float a_h = -__expf(p_alog[li * 16 + head]), dtb = p_dtb[li * 16 + head], Dh = p_d[li * 16 + head];
    bf16* proj = (bf16*)(F.ws + WS_PROJ) + (size_t)(b * SEQ + seg * 512) * PROJ_LD;
    const bf16* pB = proj + C_B + 128 * grp; const bf16* pC = proj + C_C + 128 * grp; const bf16* pX = proj + C_XS + 64 * head + 16 * ph; bf16* pZ = proj + C_Z + 64 * head + 16 * ph;
    const float* dtp = (const float*)(F.ws + WS_DT) + (size_t)(b * SEQ + seg * 512) * 16 + head;
    float* ssq = (float*)(F.ws + WS_SSQ) + (size_t)(b * SEQ + seg * 512) * 64 + grp * 32 + (head & 7) * 4 + ph;
    f32x4* Sst = (f32x4*)((unsigned char*)F.out + SSD_STATE_OFF); float* Sdec = (float*)((unsigned char*)F.out + SSD_DEC_OFF);
    const size_t sidx0 = ((size_t)((b * 16 + head) * 8) * 4 + ph) * 8 * 64 + lane;
    f32x4 sacc[8];
#pragma unroll
    for (int nt = 0; nt < 8; ++nt) sacc[nt] = (f32x4){0.f, 0.f, 0.f, 0.f};
    if (PASS == 1) {
        for (int s2 = 0; s2 < seg; ++s2) { const float dc = __expf(Sdec[(b * 16 + head) * 8 + s2]);
#pragma unroll
            for (int nt = 0; nt < 8; ++nt) sacc[nt] = sacc[nt] * dc + Sst[sidx0 + (size_t)s2 * 2048 + nt * 64]; }
    }
    float logdec = 0.f;
    const int row = tid >> 3, cseg = (tid & 7) * 8;
    u32x4 rB0, rB1, rC0, rC1, rX[2], rZ[2]; float rdt;
    { const size_t o = (size_t)row * PROJ_LD + cseg; rB0 = *(const u32x4*)(pB + o); rB1 = *(const u32x4*)(pB + o + 64); if (PASS == 1) { rC0 = *(const u32x4*)(pC + o); rC1 = *(const u32x4*)(pC + o + 64); }
      const size_t ow = (size_t)lane * PROJ_LD;
#pragma unroll
      for (int q = 0; q < 2; ++q) { rX[q] = *(const u32x4*)(pX + ow + 8 * q); if (PASS == 1) rZ[q] = *(const u32x4*)(pZ + ow + 8 * q); }
      rdt = dtp[(size_t)lane * 16]; }
    for (int c = 0; c < 8; ++c) {
        const int tok0 = c * 64;
        *(LAS u32x4*)(Bs + row * 144 + cseg) = rB0; *(LAS u32x4*)(Bs + row * 144 + cseg + 64) = rB1;
        if (PASS == 1) { *(LAS u32x4*)(Cs + row * 136 + cseg) = rC0; *(LAS u32x4*)(Cs + row * 136 + cseg + 64) = rC1; }
#pragma unroll
        for (int q = 0; q < 2; ++q) { *(LAS u32x4*)(Xw_ + lane * 24 + 8 * q) = rX[q]; if (PASS == 1) *(LAS u32x4*)(Zw_ + lane * 24 + 8 * q) = rZ[q]; }
        if (ph == 0) { const float dt = softplus_f(rdt + dtb); float cs = dt * a_h;
#pragma unroll
          for (int off = 1; off < 64; off <<= 1) { const float v = __shfl_up(cs, off); if (lane >= off) cs += v; }
          const float tot = __shfl(cs, 63);
          csw[lane] = cs; dtw[lane] = dt; ww[lane] = dt * __expf(tot - cs); logdec += tot; }
        if (c + 1 < 8) { const size_t o = (size_t)(tok0 + 64 + row) * PROJ_LD + cseg; rB0 = *(const u32x4*)(pB + o); rB1 = *(const u32x4*)(pB + o + 64); if (PASS == 1) { rC0 = *(const u32x4*)(pC + o); rC1 = *(const u32x4*)(pC + o + 64); }
            const size_t ow = (size_t)(tok0 + 64 + lane) * PROJ_LD;
#pragma unroll
            for (int q = 0; q < 2; ++q) { rX[q] = *(const u32x4*)(pX + ow + 8 * q); if (PASS == 1) rZ[q] = *(const u32x4*)(pZ + ow + 8 * q); }
            rdt = dtp[(size_t)(tok0 + 64 + lane) * 16]; }
        __syncthreads();
        if (PASS == 1) {
            { const int lt = wave >> 1; const float Dh2[2] = {p_d[li * 16 + 2 * hp], p_d[li * 16 + 2 * hp + 1]};
              const LAS float* csb = csw - (wave >> 2) * 192;
#pragma unroll
              for (int q = 0; q < 2; ++q) { const int st = 2 * (wave & 1) + q;
                  const f32x4 G = mma_lds<128>((f32x4){0.f, 0.f, 0.f, 0.f}, Cs, 136, 16 * lt, Bs, 144, 16 * st, j, g);
                  const int s = 16 * st + j;
#pragma unroll
                  for (int h2 = 0; h2 < 2; ++h2) { const LAS float* c2 = csb + h2 * 192; const float css = c2[s], dts = c2[64 + s];
#pragma unroll
                      for (int r = 0; r < 4; ++r) { const int l = 16 * lt + 4 * g + r; float v = (s <= l) ? G[r] * __expf(fminf(c2[l] - css, 0.f)) * dts : 0.f; if (s == l) v += Dh2[h2]; Gs[h2 * (64 * 72) + l * 72 + s] = (bf16)f2bf(v); } } } }
            __syncthreads();
            f32x4 yacc[4];
#pragma unroll
            for (int lt = 0; lt < 4; ++lt) yacc[lt] = (f32x4){0.f, 0.f, 0.f, 0.f};
#pragma unroll
            for (int ks = 0; ks < 4; ++ks) {
                bf16x8 sf;
                { u32x4 w; w.x = pk2(sacc[2 * ks][0], sacc[2 * ks][1]); w.y = pk2(sacc[2 * ks][2], sacc[2 * ks][3]);
                    w.z = pk2(sacc[2 * ks + 1][0], sacc[2 * ks + 1][1]); w.w = pk2(sacc[2 * ks + 1][2], sacc[2 * ks + 1][3]); sf = __builtin_bit_cast(bf16x8, w); }
#pragma unroll
                for (int lt = 0; lt < 4; ++lt) { const LAS bf16* cp = Cs + (16 * lt + j) * 136 + 32 * ks + 4 * g;
                    const u32x2 c0 = *(const LAS u32x2*)cp, c1 = *(const LAS u32x2*)(cp + 16); const u32x4 cw = (u32x4){c0.x, c0.y, c1.x, c1.y}; const bf16x8 cf = __builtin_bit_cast(bf16x8, cw);
                    yacc[lt] = MFMA16(cf, sf, yacc[lt]); } }
#pragma unroll
            for (int lt = 0; lt < 4; ++lt)
#pragma unroll
                for (int r = 0; r < 4; ++r) { const float e = __expf(csw[16 * lt + 4 * g + r]); yacc[lt][r] *= e; }
            bf16x8 xf[2];
#pragma unroll
            for (int ks = 0; ks < 2; ++ks) xf[ks] = tr_frag(Xw_, 24, 32 * ks, 0, lane);
            { const LAS bf16* Mh = Gs + (wave >> 2) * (64 * 72);
#pragma unroll
              for (int ks = 0; ks < 2; ++ks)
#pragma unroll
                for (int lt = 0; lt < 4; ++lt) { if (ks == 1 && lt < 2) continue;
                    const bf16x8 mf = *(const LAS bf16x8*)(Mh + (16 * lt + j) * 72 + 32 * ks + 8 * g);
                    yacc[lt] = MFMA16(mf, xf[ks], yacc[lt]); } }
#pragma unroll
            for (int lt = 0; lt < 4; ++lt) { float sq[4];
#pragma unroll
                for (int r = 0; r < 4; ++r) { const int l = 16 * lt + 4 * g + r; float s;
                    { const float z = bf2f(Zw_[l * 24 + j]); const float v = yacc[lt][r] * z; Zw_[l * 24 + j] = (bf16)f2bf(v); s = v * v; }
                    s += __shfl_xor(s, 1); s += __shfl_xor(s, 2); s += __shfl_xor(s, 4); s += __shfl_xor(s, 8); sq[r] = s; }
                if (j == 0) {
#pragma unroll
                    for (int r = 0; r < 4; ++r) ssq[(size_t)(tok0 + 16 * lt + 4 * g + r) * 64] = sq[r]; } }
            LDS_FENCE();
            { bf16* op = pZ + (size_t)(tok0 + lane) * PROJ_LD;
#pragma unroll
              for (int q = 0; q < 2; ++q) *(u32x4*)(op + 8 * q) = *(const LAS u32x4*)(Zw_ + lane * 24 + 8 * q); }
        }
        { const float dec = __expf(csw[63]);
          bf16x8 xwf[2];
#pragma unroll
          for (int ks = 0; ks < 2; ++ks) { float wsv[8];
              { const f32x4 w0 = *(const LAS f32x4*)(ww + 32 * ks + 8 * g), w1 = *(const LAS f32x4*)(ww + 32 * ks + 8 * g + 4);
#pragma unroll
                for (int e = 0; e < 4; ++e) { wsv[e] = w0[e]; wsv[4 + e] = w1[e]; } }
              { const bf16x8 x8 = tr_frag(Xw_, 24, 32 * ks, 0, lane); float xv[8]; unpack8(__builtin_bit_cast(u32x4, x8), xv);
#pragma unroll
                  for (int e = 0; e < 8; ++e) xv[e] *= wsv[e];
                  const u32x4 xw = pack8(xv); xwf[ks] = __builtin_bit_cast(bf16x8, xw); } }
#pragma unroll
          for (int nt = 0; nt < 8; ++nt) { const bf16x8 b0 = tr_frag(Bs, 144, 0, 16 * nt, lane), b1 = tr_frag(Bs, 144, 32, 16 * nt, lane);
              { f32x4 a = sacc[nt] * dec; a = MFMA16(b0, xwf[0], a); a = MFMA16(b1, xwf[1], a); sacc[nt] = a; } } }
        __syncthreads();
    }
    if (PASS == 0) {
#pragma unroll
        for (int nt = 0; nt < 8; ++nt) Sst[sidx0 + (size_t)seg * 2048 + nt * 64] = sacc[nt];
        if (ph == 0 && lane == 0) Sdec[(b * 16 + head) * 8 + seg] = logdec;
    }
}
__device__ __forceinline__ void ssdnorm_phase(Ctx& F, int li, const float* p_nw) {
    bf16* proj = (bf16*)(F.ws + WS_PROJ); const float* ssq = (const float*)(F.ws + WS_SSQ);
    const int gw = F.bid * NWAVES + F.wave, NGW = F.G * NWAVES, lane = F.lane;
    float nw[16];
#pragma unroll
    for (int e = 0; e < 16; ++e) nw[e] = p_nw[li * 1024 + 16 * lane + e];
    for (int m0 = gw * 4; m0 < M; m0 += NGW * 4) {
        u32x4 ra[4], rb[4]; f32x4 sp[4][8];
#pragma unroll
        for (int u = 0; u < 4; ++u) { const bf16* p = proj + (size_t)(m0 + u) * PROJ_LD + C_Z + 16 * lane; ra[u] = *(const u32x4*)p; rb[u] = *(const u32x4*)(p + 8);
            const f32x4* s4 = (const f32x4*)(ssq + (size_t)(m0 + u) * 64 + (lane >> 5) * 32);
#pragma unroll
            for (int q = 0; q < 8; ++q) sp[u][q] = s4[q]; }
#pragma unroll
        for (int u = 0; u < 4; ++u) { float ssum = 0.f;
#pragma unroll
            for (int q = 0; q < 8; ++q) ssum += (sp[u][q].x + sp[u][q].y) + (sp[u][q].z + sp[u][q].w);
            const float sc = 1.0f / sqrtf(ssum * (1.f / 512.f) + EPS); float x[16];
            unpack8(ra[u], x); unpack8(rb[u], x + 8);
#pragma unroll
            for (int e = 0; e < 16; ++e) x[e] = x[e] * sc * nw[e];
            bf16* p = proj + (size_t)(m0 + u) * PROJ_LD + C_Z + 16 * lane; *(u32x4*)p = pack8(x); *(u32x4*)(p + 8) = pack8(x + 8); }
    }
}
__device__ __forceinline__ void qknorm_phase(Ctx& F, int li, const float* p_qn, const float* p_kn) {
    bf16* qkv = (bf16*)(F.ws + WS_PROJ);
    const int gt = F.bid * NTHREADS + F.tid, NT = F.G * NTHREADS;
    const float L2T = 18.931568569324174f;
    for (int idx = gt; idx < M * 32; idx += NT) {
        const int m = idx >> 5, qk = (idx >> 4) & 1, h = idx & 15;
        bf16* p = qkv + (size_t)m * QKV_LD + qk * 1024 + h * 64;
        const float* gain = (qk ? p_kn : p_qn) + li * 64;
        float x[64]; float ss = 0.f;
#pragma unroll
        for (int q = 0; q < 8; ++q) unpack8(*(const u32x4*)(p + 8 * q), x + 8 * q);
#pragma unroll
        for (int e = 0; e < 64; ++e) ss += x[e] * x[e];
        const float rs = 1.0f / sqrtf(ss * (1.f / 64.f) + EPS);
#pragma unroll
        for (int e = 0; e < 64; ++e) x[e] = x[e] * rs * gain[e];
        const float pos = (float)(m & (SEQ - 1));
#pragma unroll
        for (int i = 0; i < 8; ++i) { const float inv = exp2f(-(float)i * 0.125f * L2T); const float ang = pos * inv;
            double rev = (double)ang * 0.15915494309189535; rev -= floor(rev); const float fr = (float)rev;
            const float sn = __builtin_amdgcn_sinf(fr), cs = __builtin_amdgcn_cosf(fr);
            const float x1 = x[i], x2 = x[i + 8]; x[i] = x1 * cs - x2 * sn; x[i + 8] = x2 * cs + x1 * sn; }
        const float sc = qk ? 1.0f : 0.125f * 1.4426950408889634f;
#pragma unroll
        for (int q = 0; q < 8; ++q) { float y[8];
#pragma unroll
            for (int e = 0; e < 8; ++e) y[e] = x[8 * q + e] * sc;
            *(u32x4*)(p + 8 * q) = pack8(y); }
    }
}
template <int NQT>
__device__ __forceinline__ void attn_first(const bf16* Qp, int d, int r, int qs, int lane, bf16x8 (&qf)[NQT][2], bf16x8 (&kf)[2][2], u32x4 (&v4)[4]) {
    const int j = lane & 15, g = lane >> 4;
#pragma unroll
    for (int qt = 0; qt < NQT; ++qt) { const bf16* qp = Qp + (size_t)(r + d * (qs + 16 * qt + j)) * QKV_LD + 8 * g; qf[qt][0] = *(const bf16x8*)qp; qf[qt][1] = *(const bf16x8*)(qp + 32); }
    const int kstart = qs + 16 * NQT - 160; const int ci0 = kstart < 0 ? (((-kstart) >> 5) < 4 ? ((-kstart) >> 5) : 4) : 0; const int kc = kstart + 32 * ci0;
#pragma unroll
    for (int tt = 0; tt < 2; ++tt) { int kidx = kc + 8 * (j >> 2) + 4 * tt + (j & 3); kidx = kidx < 0 ? 0 : kidx;
        const bf16* kp = Qp + 1024 + (size_t)(r + d * kidx) * QKV_LD + 8 * g; kf[tt][0] = *(const bf16x8*)kp; kf[tt][1] = *(const bf16x8*)(kp + 32); }
    { int kv = kc + (lane >> 1); kv = kv < 0 ? 0 : kv; const bf16* vp = Qp + 2048 + (size_t)(r + d * kv) * QKV_LD + (lane & 1) * 32;
#pragma unroll
      for (int q4 = 0; q4 < 4; ++q4) v4[q4] = *(const u32x4*)(vp + 8 * q4); }
}
template <int NQT, int MODE, int NQTN>
__device__ __forceinline__ void attn_run(const bf16x8 (&qfI)[NQT][2], const bf16x8 (&kfI)[2][2], const u32x4 (&v4I)[4],
                                         bf16x8 (&qfN)[NQTN ? NQTN : 1][2], bf16x8 (&kfN)[2][2], u32x4 (&v4N)[4], int d2, int r2, int qs2,
                                         const bf16* Qp, bf16* Op, int d, int r, int qs, int qloc0,
                                         LAS bf16* Vt, LAS float* Oacc, LAS float* Lb, int lane, const float negc) {
    const int j = lane & 15, g = lane >> 4;
    bf16x8 qf[NQT][2];
#pragma unroll
    for (int qt = 0; qt < NQT; ++qt) { qf[qt][0] = qfI[qt][0]; qf[qt][1] = qfI[qt][1]; }
    f32x4 o[NQT][4]; float lrun[NQT];
#pragma unroll
    for (int qt = 0; qt < NQT; ++qt) { lrun[qt] = 0.f;
#pragma unroll
        for (int dt = 0; dt < 4; ++dt) o[qt][dt] = (f32x4){0.f, 0.f, 0.f, 0.f}; }
    const int kstart = qs + 16 * NQT - 160;
    bf16x8 nkf[2][2]; u32x4 nv4[4];
#define ATT_LOAD(kc_) do { \
        _Pragma("unroll") for (int tt = 0; tt < 2; ++tt) { int kidx = (kc_) + 8 * (j >> 2) + 4 * tt + (j & 3); kidx = kidx < 0 ? 0 : kidx; \
            const bf16* kp = Qp + 1024 + (size_t)(r + d * kidx) * QKV_LD + 8 * g; nkf[tt][0] = *(const bf16x8*)kp; nkf[tt][1] = *(const bf16x8*)(kp + 32); } \
        { int kv = (kc_) + (lane >> 1); kv = kv < 0 ? 0 : kv; const bf16* vp = Qp + 2048 + (size_t)(r + d * kv) * QKV_LD + (lane & 1) * 32; \
          _Pragma("unroll") for (int q4 = 0; q4 < 4; ++q4) nv4[q4] = *(const u32x4*)(vp + 8 * q4); } } while (0)
    const int ci0 = kstart < 0 ? (((-kstart) >> 5) < 4 ? ((-kstart) >> 5) : 4) : 0;
#pragma unroll
    for (int tt = 0; tt < 2; ++tt) { nkf[tt][0] = kfI[tt][0]; nkf[tt][1] = kfI[tt][1]; }
#pragma unroll
    for (int q4 = 0; q4 < 4; ++q4) nv4[q4] = v4I[q4];
    for (int ci = ci0; ci < 5; ++ci) {
        const int kc = kstart + 32 * ci;
        bf16x8 kf[2][2];
#pragma unroll
        for (int tt = 0; tt < 2; ++tt) { kf[tt][0] = nkf[tt][0]; kf[tt][1] = nkf[tt][1]; }
        { u32x4 v4[4];
#pragma unroll
          for (int q4 = 0; q4 < 4; ++q4) v4[q4] = nv4[q4];
          if (ci + 1 < 5) ATT_LOAD(kc + 32);
          LDS_FENCE();
#pragma unroll
          for (int q4 = 0; q4 < 4; ++q4) *(LAS u32x4*)(Vt + (lane >> 1) * 72 + (lane & 1) * 32 + 8 * q4) = v4[q4]; }
        LDS_FENCE();
        bf16x8 vf[4];
#pragma unroll
        for (int dt = 0; dt < 4; ++dt) vf[dt] = tr_frag(Vt, 72, 0, 16 * dt, lane);
        const bool need_mask = (ci == 0) || (ci == 4) || (kc < 0);
#pragma unroll
        for (int qt = 0; qt < NQT; ++qt) {
            f32x4 s0 = (f32x4){negc, negc, negc, negc}, s1 = s0;
            s0 = MFMA16(kf[0][0], qf[qt][0], s0); s0 = MFMA16(kf[0][1], qf[qt][1], s0);
            s1 = MFMA16(kf[1][0], qf[qt][0], s1); s1 = MFMA16(kf[1][1], qf[qt][1], s1);
            float sv[8] = {s0[0], s0[1], s0[2], s0[3], s1[0], s1[1], s1[2], s1[3]};
            float pp[8], psum = 0.f;
#pragma unroll
            for (int e = 0; e < 8; ++e) pp[e] = __builtin_amdgcn_exp2f(sv[e]);
            if (need_mask) {
                const int qi = qs + 16 * qt + j;
#pragma unroll
                for (int e = 0; e < 8; ++e) { const int kidx = kc + 8 * g + e; const int diff = qi - kidx; const bool ok = (kidx >= 0) && (diff >= 0) && (diff <= 128); pp[e] = ok ? pp[e] : 0.f; }
            }
#pragma unroll
            for (int e = 0; e < 8; ++e) psum += pp[e];
            lrun[qt] += psum;
            const u32x4 pw = pack8(pp); const bf16x8 pf = __builtin_bit_cast(bf16x8, pw);
#pragma unroll
            for (int dt = 0; dt < 4; ++dt) o[qt][dt] = MFMA16(vf[dt], pf, o[qt][dt]);
        }
    }
    if (NQTN > 0) attn_first<(NQTN ? NQTN : 1)>(Qp, d2, r2, qs2, lane, qfN, kfN, v4N);
#pragma unroll
    for (int qt = 0; qt < NQT; ++qt) {
        float l = lrun[qt]; l += __shfl_xor(l, 16); l += __shfl_xor(l, 32);
        const int qloc = qloc0 + d * (16 * qt + j);
        if (MODE == 0) {
#pragma unroll
            for (int dt = 0; dt < 4; ++dt) *(LAS f32x4*)(Oacc + qloc * 68 + 16 * dt + 4 * g) = o[qt][dt];
            if (g == 0) Lb[qloc] = l;
        } else {
            const float ln = Lb[qloc] + l;
            LDS_FENCE();
            if (MODE == 1) {
#pragma unroll
                for (int dt = 0; dt < 4; ++dt) { LAS f32x4* p4 = (LAS f32x4*)(Oacc + qloc * 68 + 16 * dt + 4 * g); *p4 = *p4 + o[qt][dt]; }
                if (g == 0) Lb[qloc] = ln;
            } else {
                const float inv = 1.0f / ln; bf16* op = Op + (size_t)(r + d * (qs + 16 * qt + j)) * QKV_LD;
#pragma unroll
                for (int dt = 0; dt < 4; ++dt) { float y[4]; const f32x4 a4 = *(const LAS f32x4*)(Oacc + qloc * 68 + 16 * dt + 4 * g);
#pragma unroll
                    for (int rr = 0; rr < 4; ++rr) y[rr] = (a4[rr] + o[qt][dt][rr]) * inv;
                    u32x2 w; w.x = pk2(y[0], y[1]); w.y = pk2(y[2], y[3]); *(u32x2*)(op + 16 * dt + 4 * g) = w; }
            }
        }
    }
    LDS_FENCE();
#undef ATT_LOAD
}
__device__ __forceinline__ void attn_item(Ctx& F, int b, int h, int blk, const float negc) {
    bf16* base = (bf16*)(F.ws + WS_PROJ) + (size_t)b * SEQ * QKV_LD + h * 64;
    const bf16* Qp = base;
    const int wave = F.wave, lane = F.lane, T0 = blk * 256;
    bf16* Ob = base;
    LAS bf16* Vt = (LAS bf16*)(F.lds + wave * 5120);
    LAS float* Oacc = (LAS float*)(F.lds + 40960); LAS float* Lb = Oacc + 256 * 68;
    bf16x8 qA[2][2], kA[2][2]; u32x4 vA[4]; attn_first<2>(Qp, 1, 0, T0 + 32 * wave, lane, qA, kA, vA);
    bf16x8 qB[2][2], kB[2][2]; u32x4 vB[4];
    attn_run<2, 0, 2>(qA, kA, vA, qB, kB, vB, 4, wave >> 1, T0 / 4 + 32 * (wave & 1), Qp, Ob, 1, 0, T0 + 32 * wave, 32 * wave, Vt, Oacc, Lb, lane, negc);
    __syncthreads();
    bf16x8 qC[1][2], kC[2][2]; u32x4 vC[4];
    attn_run<2, 1, 1>(qB, kB, vB, qC, kC, vC, 16, 2 * wave, T0 / 16, Qp, Ob, 4, wave >> 1, T0 / 4 + 32 * (wave & 1), (wave >> 1) + 128 * (wave & 1), Vt, Oacc, Lb, lane, negc);
    __syncthreads();
    bf16x8 qD[1][2], kD[2][2]; u32x4 vD[4];
    attn_run<1, 2, 1>(qC, kC, vC, qD, kD, vD, 16, 2 * wave + 1, T0 / 16, Qp, Ob, 16, 2 * wave, T0 / 16, 2 * wave, Vt, Oacc, Lb, lane, negc);
    bf16x8 qE[1][2], kE[2][2]; u32x4 vE[4];
    attn_run<1, 2, 0>(qD, kD, vD, qE, kE, vE, 0, 0, 0, Qp, Ob, 16, 2 * wave + 1, T0 / 16, 2 * wave + 1, Vt, Oacc, Lb, lane, negc);
    __syncthreads();
}
#define XB_TMO      128
#define XB_XCNT(j)  (256  + 64 * (j))
#define XB_XSUB(j)  (1280 + 64 * (j))
#define XB_XGEN(j)  (2304 + 64 * (j))
#define XB_TOP      3328
#define XB_TOPGEN   3392
#define XCD_BAR_WORDS 3456
#define XB_SPIN_CAP (1u << 18)

__device__ __forceinline__ unsigned xb_ld(unsigned* p)              { return __hip_atomic_load(p, __ATOMIC_RELAXED, __HIP_MEMORY_SCOPE_AGENT); }
__device__ __forceinline__ unsigned xb_add(unsigned* p, unsigned v) { return __hip_atomic_fetch_add(p, v, __ATOMIC_RELAXED, __HIP_MEMORY_SCOPE_AGENT); }
__device__ __forceinline__ unsigned xb_xcc_id() { return (unsigned)__builtin_amdgcn_s_getreg((3 << 11) | 20) & 0xFu; }
#define XB_SPIN(cond, bar) do { unsigned _sp = 0; while (cond) { __builtin_amdgcn_s_sleep(1); \
    if ((++_sp & 255u) == 0u) { if (xb_ld(&(bar)[XB_TMO])) break; if (_sp > XB_SPIN_CAP) { atomicAdd(&(bar)[XB_TMO], 1u); break; } } } } while (0)

struct XcdBarrier {
    unsigned* bar; unsigned x;
    volatile LAS unsigned* st;
};

__device__ __forceinline__ XcdBarrier xcd_barrier_post(unsigned* bar, volatile LAS unsigned* st) {
    XcdBarrier b; b.bar = bar; b.x = xb_xcc_id(); b.st = st;
    if (threadIdx.x == 0) (void)xb_add(&bar[XB_XCNT(b.x)], 1u);
    return b;
}
__device__ __forceinline__ void xcd_barrier_complete(unsigned* bar, unsigned x, unsigned& nloc, unsigned& nx) {
    const unsigned G = gridDim.x * gridDim.y * gridDim.z;
    unsigned sum, cnt, mine, sp = 0u;
    for (;;) {
        sum = 0u; cnt = 0u; mine = 0u;
#pragma unroll
        for (unsigned j = 0; j < 16; ++j) { const unsigned c = xb_ld(&bar[XB_XCNT(j)]); sum += c; cnt += (c > 0u) ? 1u : 0u; mine = (j == x) ? c : mine; }
        if (sum == G) break;
        __builtin_amdgcn_s_sleep(1);
        if ((++sp & 255u) == 0u) { if (xb_ld(&bar[XB_TMO])) break; if (sp > XB_SPIN_CAP) { atomicAdd(&bar[XB_TMO], 1u); break; } }
    }
    nloc = mine > 0u ? mine : 1u; nx = cnt > 0u ? cnt : 1u;
}

__device__ __forceinline__ void xcd_barrier(const XcdBarrier& b) {
    asm volatile("s_waitcnt vmcnt(0)" ::: "memory");
    __syncthreads();
    if (threadIdx.x == 0) {
        unsigned* bar = b.bar;
        __builtin_amdgcn_s_waitcnt(0);
        unsigned nloc = b.st[0], nx = b.st[1];
        if (nloc == 0u) { xcd_barrier_complete(bar, b.x, nloc, nx); b.st[0] = nloc; b.st[1] = nx; }
        const unsigned old = xb_add(&bar[XB_XSUB(b.x)], 1u);
        const unsigned gen = old / nloc;
        if (old + 1u == (gen + 1u) * nloc) {
            __builtin_amdgcn_fence(__ATOMIC_RELEASE, "agent");
            asm volatile("s_waitcnt vmcnt(0)" ::: "memory");
            const unsigned og = xb_add(&bar[XB_TOP], 1u);
            const unsigned tg = og / nx;
            if (og + 1u == (tg + 1u) * nx) xb_add(&bar[XB_TOPGEN], 1u);
            else XB_SPIN(xb_ld(&bar[XB_TOPGEN]) == tg, bar);
            __builtin_amdgcn_fence(__ATOMIC_ACQUIRE, "agent");
            xb_add(&bar[XB_XGEN(b.x)], 1u);
            asm volatile("s_waitcnt vmcnt(0)" ::: "memory");
        } else {
            XB_SPIN(xb_ld(&bar[XB_XGEN(b.x)]) == gen, bar);
            __builtin_amdgcn_fence(__ATOMIC_ACQUIRE, "agent");
            asm volatile("s_waitcnt vmcnt(0)" ::: "memory");
        }
    }
    __syncthreads();
}

constexpr int BAR_ST_OFF = LDS_BYTES - 64;
struct Args { const float* in[25]; float* out; unsigned char* ws; int ph_lo, ph_hi; };
static_assert(sizeof(Args) == 224, "Args layout");
#ifndef PG8_SP2
#define PG8_SP2 true
#endif
#ifndef PG8_ALIGN
#define PG8_ALIGN true
#endif
__device__ __forceinline__ void rs_prologue(Ctx& F, const pg8::StaticOrder& S) {
    LAS float* rsl = (LAS float*)(F.lds + 131072); LAS int* pmt = (LAS int*)(F.lds + 131072 + 4096);
    int p0 = -1, p1 = -1, p2 = -1, p3 = -1; pg8::Unit u;
    for (int i = 0; S.next(i, u); ++i) { const int pm = u.pm; if (pm == p0 || pm == p1 || pm == p2 || pm == p3) continue;
        if (p0 < 0) p0 = pm; else if (p1 < 0) p1 = pm; else if (p2 < 0) p2 = pm; else if (p3 < 0) p3 = pm; }
    const float* rs = (const float*)(F.ws + WS_RS);
#pragma unroll
    for (int q = 0; q < 2; ++q) { const int idx = F.tid + 512 * q, slot = idx >> 8, r = idx & 255; const int pm = slot == 0 ? p0 : slot == 1 ? p1 : slot == 2 ? p2 : p3;
        if (pm >= 0) rsl[idx] = pg8::row_rs(rs, pm * 256 + r); }
    if (F.tid == 0) { pmt[0] = p0; pmt[1] = p1; pmt[2] = p2; pmt[3] = p3; }
    __syncthreads();
}
__device__ __forceinline__ void gemm_proj(Ctx& F, const bf16* A, int lda, const bf16* Bt, int N, int K, bf16* O, int ldc, float* dt, int dt_pn) {
    const float* rs = (const float*)(F.ws + WS_RS); bf16* halo = dt ? (bf16*)(F.ws + WS_HALO) : nullptr;
    pg8::Gemm g{A, Bt, M, N, K, lda}; pg8::StaticOrder S; S.init(M, N, F.G, F.bid);
    rs_prologue(F, S);
    pg8::EpiProj E{F.lds + 131072, O, ldc, dt, dt_pn, rs, halo};
    pg8::gemm_phase<pg8::EpiProj, pg8::StaticOrder, PG8_ALIGN, PG8_SP2>(F.lds, g, S, E, F.tid);
}
__device__ __forceinline__ void gemm_qkv(Ctx& F, const bf16* A, const bf16* Bt, bf16* O, const float* gq, const float* gk) {
    pg8::Gemm g{A, Bt, M, QKV_LD, DM, DM}; pg8::StaticOrder S; S.init(M, QKV_LD, F.G, F.bid);
    rs_prologue(F, S);
    pg8::EpiQKV E{F.lds + 131072, O, QKV_LD, (const float*)(F.ws + WS_RS), gq, gk};
    pg8::gemm_phase<pg8::EpiQKV, pg8::StaticOrder, PG8_ALIGN, PG8_SP2>(F.lds, g, S, E, F.tid);
}
__device__ __forceinline__ void gemm_swiglu(Ctx& F, const bf16* A, const bf16* Bt, bf16* O) {
    pg8::Gemm g{A, Bt, M, GU_N, DM, DM}; pg8::StaticOrder S; S.init(M, GU_N, F.G, F.bid);
    rs_prologue(F, S);
    pg8::EpiSwiglu E{F.lds + 131072, O, FFN_H, (const float*)(F.ws + WS_RS)};
    pg8::gemm_phase<pg8::EpiSwiglu, pg8::StaticOrder, PG8_ALIGN, PG8_SP2>(F.lds, g, S, E, F.tid);
}
__device__ __forceinline__ void gemm_res(Ctx& F, const bf16* A, int lda, const bf16* Bt, int K, const float* basef, float* outf) {
    pg8::Gemm g{A, Bt, M, DM, K, lda}; pg8::StaticOrder S; S.init(M, DM, F.G, F.bid);
    pg8::EpiRes E{basef, outf, DM, (bf16*)(F.ws + WS_H), (float*)(F.ws + WS_RS)};
    pg8::gemm_phase<pg8::EpiRes, pg8::StaticOrder, PG8_ALIGN, PG8_SP2>(F.lds, g, S, E, F.tid);
}

__global__ void __launch_bounds__(NTHREADS, 2) trunk_fwd(Args args) {
    extern __shared__ __attribute__((aligned(16))) unsigned char lds_raw[];
    cg::grid_group grid = cg::this_grid();
    Ctx F;
    F.lds = (LAS unsigned char*)lds_raw; F.tid = threadIdx.x; F.lane = F.tid & 63; F.wave = __builtin_amdgcn_readfirstlane(F.tid >> 6); F.G = gridDim.x; F.bid = blockIdx.x;
#define Hb ((bf16*)(F.ws + WS_H))
#define PJ ((bf16*)(F.ws + WS_PROJ))
#define KAS __attribute__((address_space(4)))
#define KIN(k) (*(const float* KAS const*)(karg + 8 * (k)))
    KAS unsigned char* karg0 = (KAS unsigned char*)__builtin_amdgcn_kernarg_segment_ptr();
#ifdef PROBE_MASK
    unsigned long long pt_prev = __builtin_amdgcn_s_memrealtime(), pt_acc = 0ull;
#define PROBE_STAMP() do { const unsigned long long t_ = __builtin_amdgcn_s_memrealtime(); if ((PROBE_MASK >> pk_) & 1) pt_acc += t_ - pt_prev; pt_prev = t_; } while (0)
#else
#define PROBE_STAMP() do {} while (0)
#endif
    int pk_ = 0;
    if (threadIdx.x < 16) ((LAS unsigned*)(F.lds + BAR_ST_OFF))[threadIdx.x] = 0u;
    __syncthreads();
    const int lo = *(KAS const int*)(karg0 + 216), hi = *(KAS const int*)(karg0 + 220); int ph = 0;
#define PHASE_BEGIN_K(kind) pk_ = (kind); if (ph >= lo && ph < hi) { KAS unsigned char* karg = karg0; { int t_ = threadIdx.x, b_ = blockIdx.x, g_ = gridDim.x; asm volatile("" : "+s"(karg), "+v"(t_), "+s"(b_), "+s"(g_)); F.ws = *(unsigned char* KAS const*)(karg + 208); F.out = *(float* KAS const*)(karg + 200); F.tid = t_; F.lane = t_ & 63; F.wave = __builtin_amdgcn_readfirstlane(t_ >> 6); F.bid = b_; F.G = g_; }
#define PHASE_END if (ph + 1 < hi) { asm volatile("s_waitcnt vmcnt(0) lgkmcnt(0)" ::: "memory"); if (ph == 0) { grid.sync(); __builtin_amdgcn_fence(__ATOMIC_ACQUIRE, "agent"); asm volatile("s_waitcnt vmcnt(0)" ::: "memory"); __syncthreads(); (void)xcd_barrier_post((unsigned*)(F.ws + WS_CTL), (volatile LAS unsigned*)(F.lds + BAR_ST_OFF)); } else { XcdBarrier xb_; xb_.bar = (unsigned*)(F.ws + WS_CTL); xb_.x = xb_xcc_id(); xb_.st = (volatile LAS unsigned*)(F.lds + BAR_ST_OFF); xcd_barrier(xb_); } PROBE_STAMP(); } } ++ph;

    PHASE_BEGIN_K(0) if (F.bid == 0) { for (int i = F.tid; i < XCD_BAR_WORDS; i += NTHREADS) ((unsigned*)(F.ws + WS_CTL))[i] = 0u; }
        p0_weights(F, KIN(2), KIN(16), KIN(18), KIN(21), KIN(23), KIN(24), KIN(5), KIN(7), KIN(1), KIN(17), KIN(22), KIN(0)); PHASE_END
#pragma unroll 1
    for (int layer = 0; layer < DEPTH; ++layer) {
        const int li = layer >> 1;

        if ((layer & 1) == 0) {
            PHASE_BEGIN_K(2)
                gemm_proj(F, Hb, DM, (const bf16*)(F.ws + W_REC_IN + li * SZ_REC_IN), 4608, DM, PJ, PROJ_LD, (float*)(F.ws + WS_DT), -1);
            PHASE_END
            PHASE_BEGIN_K(4) conv_phase(F, li, KIN(3), KIN(4), KIN(10), KIN(11)); PHASE_END
            PHASE_BEGIN_K(5)
                if (F.G >= 256) { if (F.bid < 128) { lru_item(F, li, F.bid >> 4, F.bid & 15, KIN(6), KIN(8), KIN(9)); }
                                  else for (int it = F.bid - 128; it < 512; it += F.G - 128) { ssd_seg_item<0>(F, li, it >> 6, (it >> 3) & 7, it & 7, KIN(12), KIN(13), KIN(14)); __syncthreads(); } }
                else for (int it = F.bid; it < 640; it += F.G) { if (it < 128) lru_item(F, li, it >> 4, it & 15, KIN(6), KIN(8), KIN(9)); else ssd_seg_item<0>(F, li, (it - 128) >> 6, ((it - 128) >> 3) & 7, (it - 128) & 7, KIN(12), KIN(13), KIN(14)); __syncthreads(); }
            PHASE_END
            PHASE_BEGIN_K(5)
                for (int it = F.bid, k_ = 0; it < 512; it += F.G, ++k_) { const int sg_ = (k_ & 1) ? 7 - (it & 7) : (it & 7); ssd_seg_item<1>(F, li, it >> 6, (it >> 3) & 7, sg_, KIN(12), KIN(13), KIN(14)); __syncthreads(); }
            PHASE_END
            PHASE_BEGIN_K(6) ssdnorm_phase(F, li, KIN(15)); PHASE_END
            PHASE_BEGIN_K(7)
                gemm_res(F, PJ + C_GATE, PROJ_LD, (const bf16*)(F.ws + W_REC_OUT + li * SZ_REC_OUT), REC_OUT, (layer == 0) ? KIN(0) : nullptr, nullptr);
            PHASE_END
        } else {
            PHASE_BEGIN_K(8) gemm_qkv(F, Hb, (const bf16*)(F.ws + W_QKV + li * SZ_QKV), PJ, KIN(19) + li * 64, KIN(20) + li * 64); PHASE_END
            PHASE_BEGIN_K(10)
#ifdef PROBE_REP_ATTN
                float negc_; { float gq = fabsf(KIN(19)[li * 64 + F.lane]), gk = fabsf(KIN(20)[li * 64 + F.lane]);
#pragma unroll
                  for (int o_ = 1; o_ < 64; o_ <<= 1) { gq = fmaxf(gq, __shfl_xor(gq, o_)); gk = fmaxf(gk, __shfl_xor(gk, o_)); }
                  negc_ = -(8.0f * 1.4426950408889634f) * gq * gk; }
                for (int it = F.bid; it < BATCH * 16 * 16; it += F.G) { int h_ = (it >> 4) & 15, blk_ = it & 15; if (F.G == 256) { const int x_ = F.bid & 7, m_ = F.bid >> 3; h_ = 2 * x_ + (m_ >> 4); blk_ = ((m_ & 15) + 2 * (it >> 8)) & 15; }
                    attn_item(F, it >> 8, h_, blk_, negc_); }
#endif
                float negc_; { float gq = fabsf(KIN(19)[li * 64 + F.lane]), gk = fabsf(KIN(20)[li * 64 + F.lane]);
#pragma unroll
                  for (int o_ = 1; o_ < 64; o_ <<= 1) { gq = fmaxf(gq, __shfl_xor(gq, o_)); gk = fmaxf(gk, __shfl_xor(gk, o_)); }
                  negc_ = -(8.0f * 1.4426950408889634f) * gq * gk; }
                for (int it = F.bid; it < BATCH * 16 * 16; it += F.G) { int h_ = (it >> 4) & 15, blk_ = it & 15; if (F.G == 256) { const int x_ = F.bid & 7, m_ = F.bid >> 3; h_ = 2 * x_ + (m_ >> 4); blk_ = ((m_ & 15) + 2 * (it >> 8)) & 15; }
                    attn_item(F, it >> 8, h_, blk_, negc_); }
            PHASE_END
            PHASE_BEGIN_K(11) gemm_res(F, PJ, QKV_LD, (const bf16*)(F.ws + W_ATT_OUT + li * SZ_ATT_OUT), DM, nullptr, nullptr); PHASE_END
        }
#ifdef PROBE_REP_GU
#pragma unroll 1
        for (int rep = 0; rep < 2; ++rep) { --ph;
        PHASE_BEGIN_K(12) gemm_swiglu(F, Hb, (const bf16*)(F.ws + W_GU + layer * SZ_GU), PJ); PHASE_END
        } ++ph;
#else
        PHASE_BEGIN_K(12) gemm_swiglu(F, Hb, (const bf16*)(F.ws + W_GU + layer * SZ_GU), PJ); PHASE_END
#endif
        PHASE_BEGIN_K(13) gemm_res(F, PJ, FFN_H, (const bf16*)(F.ws + W_DOWN + layer * SZ_DOWN), FFN_H, nullptr, (layer == DEPTH - 1) ? F.out : nullptr); PHASE_END
    }
#ifdef PROBE_MASK
    { asm volatile("s_waitcnt vmcnt(0) lgkmcnt(0)" ::: "memory"); grid.sync(); const unsigned long long t_ = __builtin_amdgcn_s_memrealtime(); if ((PROBE_MASK >> pk_) & 1) pt_acc += t_ - pt_prev;
      if (blockIdx.x == 0 && threadIdx.x == 0) { float* o_ = *(float* KAS const*)(karg0 + 200); o_[0] += (float)pt_acc * 0.01f; } }
#endif
}
constexpr int N_PHASES = 1 + 2 * 8 + 2 * 5;

extern "C" void kernel_launch(void* const* d_in, const int* in_sizes, int n_in, void* d_out, int out_size, void* d_ws, size_t ws_size, hipStream_t stream) {
    static int grid = 0;
    if (grid == 0) {
        if (n_in != 25 || in_sizes[0] != M * DM || out_size != M * DM || ws_size < WS_END) { fprintf(stderr, "kernel_launch: unexpected shapes (n_in %d, in0 %d, out %d, ws %zu)\n", n_in, n_in > 0 ? in_sizes[0] : -1, out_size, ws_size); grid = -1; return; }
        int dev = 0, cus = 0, per_cu = 0;
        (void)hipGetDevice(&dev); (void)hipDeviceGetAttribute(&cus, hipDeviceAttributeMultiprocessorCount, dev);
        if (hipFuncSetAttribute((const void*)trunk_fwd, hipFuncAttributeMaxDynamicSharedMemorySize, LDS_BYTES) != hipSuccess) { fprintf(stderr, "kernel_launch: hipFuncSetAttribute failed\n"); grid = -1; return; }
        if (hipOccupancyMaxActiveBlocksPerMultiprocessor(&per_cu, (const void*)trunk_fwd, NTHREADS, LDS_BYTES) != hipSuccess || per_cu < 1) { fprintf(stderr, "kernel_launch: occupancy query says %d\n", per_cu); per_cu = 1; }
        (void)hipGetLastError();
        grid = cus * 1;
        fprintf(stderr, "kernel_launch: grid %d (cus %d, per_cu %d)\n", grid, cus, per_cu);
    }
    if (grid < 0) return;
    Args a{};
    for (int i = 0; i < 25; ++i) a.in[i] = (const float*)d_in[i];
    a.out = (float*)d_out; a.ws = (unsigned char*)d_ws; a.ph_lo = 0; a.ph_hi = N_PHASES;
    void* kargs[] = {&a};
    hipError_t e = hipLaunchCooperativeKernel((const void*)trunk_fwd, dim3(grid), dim3(NTHREADS), kargs, LDS_BYTES, stream);
    if (e != hipSuccess) fprintf(stderr, "kernel_launch: cooperative launch failed: %s (grid %d)\n", hipGetErrorString(e), grid);
}
```
